# Optimizing an MI355X kernel written in HIP

```python
import math
import jax, jax.numpy as jnp
from jax import lax
import numpy as np

D_MODEL = 1024
BATCH = 16
SEQ = 2048
DEPTH = 2

HEAD_DIM = 64
H_A = D_MODEL // HEAD_DIM
KV_A = 4
G_A = H_A // KV_A
WINDOW_A = 128
BLOCK_A = 128
H_B = D_MODEL // HEAD_DIM
DILATED_GROUPS = ((128, 1), (512, 4), (2048, 16))
N_GROUPS_B = len(DILATED_GROUPS)
BLOCK_B = 64
D_FF = -(-8 * D_MODEL // (3 * 256)) * 256
RMS_EPS = 1e-6
NEG = -1e30

kernel_name = "hybrid_window_gqa_dilated_attn_encoder"


def rmsnorm(x, g):
    x32 = x.astype(jnp.float32)
    y = x32 * lax.rsqrt(jnp.mean(x32 * x32, axis=-1, keepdims=True) + RMS_EPS)
    return (y * g.astype(jnp.float32)).astype(x.dtype)


def alibi_slopes(n):
    return 2.0 ** (-8.0 * jnp.arange(1, n + 1, dtype=jnp.float32) / n)


def banded_attention(q, k, v, slopes, dist_unit, window, block):
    n, L, hk, g, dh = q.shape
    c = window // block
    nb = -(-L // block)
    lp = nb * block
    kw = (2 * c + 1) * block
    qb = jnp.pad(q, ((0, 0), (0, lp - L), (0, 0), (0, 0), (0, 0))).reshape(n, nb, block, hk, g, dh)
    pad_k = ((0, 0), (window, window + lp - L), (0, 0), (0, 0))
    kb = jnp.pad(k, pad_k).reshape(n, nb + 2 * c, block, hk, dh)
    vb = jnp.pad(v, pad_k).reshape(n, nb + 2 * c, block, hk, dh)
    kwin = jnp.concatenate([kb[:, j:j + nb] for j in range(2 * c + 1)], axis=2)
    vwin = jnp.concatenate([vb[:, j:j + nb] for j in range(2 * c + 1)], axis=2)
    scores = jnp.einsum('nbqhgd,nbkhd->nbhgqk', qb, kwin,
                        preferred_element_type=jnp.float32) * (dh ** -0.5)
    rel = jnp.arange(kw)[None, :] - window - jnp.arange(block)[:, None]
    key_pos = jnp.arange(nb)[:, None] * block - window + jnp.arange(kw)[None, :]
    valid = (jnp.abs(rel)[None] <= window) & ((key_pos >= 0) & (key_pos < L))[:, None, :]
    dist = jnp.abs(rel).astype(jnp.float32) * dist_unit
    scores = scores - slopes.astype(jnp.float32)[:, :, None, None] * dist
    scores = jnp.where(valid[None, :, None, None], scores, NEG)
    m = jnp.max(scores, axis=-1)
    p = jnp.exp(scores - m[..., None])
    den = jnp.sum(p, axis=-1)
    lse = m + jnp.log(den)
    out = jnp.einsum('nbhgqk,nbkhd->nbqhgd', p.astype(v.dtype), vwin,
                     preferred_element_type=jnp.float32)
    out = out / jnp.moveaxis(den, -1, 2)[..., None]
    out = out.reshape(n, lp, hk, g, dh)[:, :L]
    lse = jnp.moveaxis(lse, -1, 2).reshape(n, lp, hk, g)[:, :L]
    return out.astype(q.dtype), lse


def window_gqa_sink(h, w_qkv, w_out, sink):
    b, s, _ = h.shape
    qkv = h @ w_qkv
    q = qkv[..., :H_A * HEAD_DIM].reshape(b, s, KV_A, G_A, HEAD_DIM)
    k = qkv[..., H_A * HEAD_DIM:(H_A + KV_A) * HEAD_DIM].reshape(b, s, KV_A, HEAD_DIM)
    v = qkv[..., (H_A + KV_A) * HEAD_DIM:].reshape(b, s, KV_A, HEAD_DIM)
    slopes = alibi_slopes(H_A).reshape(KV_A, G_A)
    o, lse = banded_attention(q, k, v, slopes, 1, WINDOW_A, BLOCK_A)
    o = o * jax.nn.sigmoid(lse - sink.astype(jnp.float32).reshape(KV_A, G_A))[..., None]
    return o.astype(h.dtype).reshape(b, s, H_A * HEAD_DIM) @ w_out


def to_residue(t, dil):
    b, s, hh, dh = t.shape
    return t.reshape(b, s // dil, dil, hh, dh).transpose(0, 2, 1, 3, 4).reshape(b * dil, s // dil, hh, dh)


def from_residue(t, b, dil):
    rest = t.shape[2:]
    L = t.shape[1]
    t = t.reshape((b, dil, L) + rest)
    t = jnp.swapaxes(t, 1, 2)
    return t.reshape((b, L * dil) + rest)


def dilated_mixture_attention(h, w_qkv, w_out):
    b, s, _ = h.shape
    qkv = (h @ w_qkv).reshape(b, s, N_GROUPS_B, 3, H_B, HEAD_DIM)
    slopes = alibi_slopes(H_B)[:, None]
    outs, lses = [], []
    for gi, (win, dil) in enumerate(DILATED_GROUPS):
        q = to_residue(qkv[:, :, gi, 0], dil)[:, :, :, None]
        k = to_residue(qkv[:, :, gi, 1], dil)
        v = to_residue(qkv[:, :, gi, 2], dil)
        o, lse = banded_attention(q, k, v, slopes, dil, win // (2 * dil), BLOCK_B)
        outs.append(from_residue(o[:, :, :, 0], b, dil))
        lses.append(from_residue(lse[:, :, :, 0], b, dil))
    wts = jax.nn.softmax(jnp.stack(lses), axis=0)
    o = jnp.einsum('gbsh,gbshd->bshd', wts, jnp.stack(outs).astype(jnp.float32))
    return o.astype(h.dtype).reshape(b, s, H_B * HEAD_DIM) @ w_out


def swiglu(h, w_gate, w_up, w_down):
    return (jax.nn.silu(h @ w_gate) * (h @ w_up)) @ w_down


def setup_inputs(seed: int = 0) -> dict:
    key = jax.random.key(seed)
    ks = jax.random.split(key, 14)
    n_a = (DEPTH + 1) // 2
    n_b = DEPTH // 2
    qkv_a = (H_A + 2 * KV_A) * HEAD_DIM
    qkv_b = N_GROUPS_B * 3 * H_B * HEAD_DIM
    f32 = jnp.float32

    def w(k, shape, fan_in):
        return jax.random.normal(k, shape, f32) * fan_in ** -0.5

    return {
        "x": jax.random.normal(ks[0], (BATCH, SEQ, D_MODEL), f32),
        "norm_mix": 1.0 + 0.02 * jax.random.normal(ks[1], (DEPTH, D_MODEL), f32),
        "norm_ffn": 1.0 + 0.02 * jax.random.normal(ks[2], (DEPTH, D_MODEL), f32),
        "w_qkv_a": w(ks[3], (n_a, D_MODEL, qkv_a), D_MODEL),
        "w_out_a": w(ks[4], (n_a, H_A * HEAD_DIM, D_MODEL), H_A * HEAD_DIM),
        "sink_a": 0.5 * jax.random.normal(ks[5], (n_a, H_A), f32),
        "w_qkv_b": w(ks[6], (n_b, D_MODEL, qkv_b), D_MODEL),
        "w_out_b": w(ks[7], (n_b, H_B * HEAD_DIM, D_MODEL), H_B * HEAD_DIM),
        "w_gate": w(ks[8], (DEPTH, D_MODEL, D_FF), D_MODEL),
        "w_up": w(ks[9], (DEPTH, D_MODEL, D_FF), D_MODEL),
        "w_down": w(ks[10], (DEPTH, D_FF, D_MODEL), D_FF),
        "norm_final": 1.0 + 0.02 * jax.random.normal(ks[11], (D_MODEL,), f32),
    }


def reference(x, norm_mix, norm_ffn, w_qkv_a, w_out_a, sink_a, w_qkv_b, w_out_b,
              w_gate, w_up, w_down, norm_final):
    for i in range(DEPTH):
        h = rmsnorm(x, norm_mix[i])
        j = i // 2
        if i % 2 == 0:
            x = x + window_gqa_sink(h, w_qkv_a[j], w_out_a[j], sink_a[j])
        else:
            x = x + dilated_mixture_attention(h, w_qkv_b[j], w_out_b[j])
        h = rmsnorm(x, norm_ffn[i])
        x = x + swiglu(h, w_gate[i], w_up[i], w_down[i])
    return rmsnorm(x, norm_final)
```

```cpp
#include <hip/hip_runtime.h>
#include <hip/hip_cooperative_groups.h>
#include <cstdio>
#include <cstdint>
namespace cg = cooperative_groups;
namespace pg8 {
#define PG8_LAS __attribute__((address_space(3)))
typedef unsigned short bf16_t;
typedef short bf16x8 __attribute__((ext_vector_type(8)));
typedef float f32x4 __attribute__((ext_vector_type(4)));
typedef unsigned u32x4 __attribute__((ext_vector_type(4)));
constexpr int BM = 256, BK = 64, HALF = 128, HTB = HALF * BK * 2  , STAGE_BYTES = 8 * HTB, NXCD = 8, WGM = 8;

__host__ __device__ __forceinline__ int lds_byte(int r, int c) { const int st = (r >> 4) * 2 + (c >> 5), rr = r & 15, cc = c & 31, ob = rr * 64 + cc * 2; return st * 1024 + (ob ^ (((ob >> 9) & 1) << 5)); }
__host__ __device__ __forceinline__ void stage_rc(int b, int& R, int& C) { const int st = b / 1024, sb = b % 1024, swz = sb ^ (((sb >> 9) & 1) << 5); R = (st >> 1) * 16 + swz / 64; C = (st & 1) * 32 + (swz % 64) / 2; }
__host__ __device__ __forceinline__ int perm32(int rho) { const int n = rho >> 4, i = rho & 15; return 8 * (i >> 2) + 4 * n + (i & 3); }

struct Unit { int pm, pn; };
struct Gemm { const bf16_t* A; const bf16_t* Bt; int M, N, K; };

struct StaticOrder {
    int nM, nN, nwg, G, c;
    __host__ __device__ void init(int M, int N, int G_, int c_) { nM = M / BM; nN = N / BM; nwg = nM * nN; G = G_; c = c_; }
    __host__ __device__ bool next(int i, Unit& u) const {
        const long L = (long)i * G + c; if (L >= nwg) return false;
        int wgid = (int)L; { const int q = nwg / NXCD, r = nwg % NXCD, xcd = wgid % NXCD, off = wgid / NXCD; wgid = (xcd < r ? xcd * (q + 1) : r * (q + 1) + (xcd - r) * q) + off; }
        const int nig = WGM * nN, gid = wgid / nig, fm = gid * WGM, gsz = (nM - fm) < WGM ? (nM - fm) : WGM;
        u.pm = fm + ((wgid % nig) % gsz); u.pn = (wgid % nig) / gsz; return true;
    }
    __device__ __forceinline__ void a_ready(const Unit&) const {}
    __device__ __forceinline__ void done(const Unit&) const {}
};

__device__ __forceinline__ unsigned cvt_pk_bf16(float lo, float hi) { unsigned r; asm volatile("v_cvt_pk_bf16_f32 %0, %1, %2" : "=v"(r) : "v"(lo), "v"(hi)); return r; }
constexpr float RMS_EPS_F = 1e-6f;
constexpr float QK_C2 = 0.125f * 1.4426950408889634f;
__device__ __forceinline__ float row_rscale(const float* ssqp, int row, int fq) {
    const f32x4 p = *(const f32x4*)(ssqp + (size_t)row * 16 + 4 * fq);
    float s = (p[0] + p[1]) + (p[2] + p[3]);
    s += __shfl_xor(s, 16); s += __shfl_xor(s, 32);
    return rsqrtf(s * (1.0f / 1024.0f) + RMS_EPS_F);
}
struct EpiQKV {
    static constexpr bool PERM = true, AFTER_DRAIN = false;
    bf16_t* O; int ldc; const float* ssqp; int qtiles;
    __device__ __forceinline__ void operator()(const f32x4 (&acc)[2][2][4][2], const Unit& u, int wr, int wc, int fr, int fq) const {
        const int row0 = u.pm * BM + wr * 64 + fr, col0 = u.pn * BM + wc * 32 + 8 * fq;
        const float sc = (u.pn < qtiles) ? QK_C2 : 1.0f;
#pragma unroll
        for (int ai = 0; ai < 2; ++ai)
#pragma unroll
            for (int m = 0; m < 4; ++m) { const int row = row0 + ai * HALF + m * 16; const float r = row_rscale(ssqp, row, fq) * sc;
                bf16_t* rowp = O + (size_t)row * ldc + col0;
#pragma unroll
                for (int bj = 0; bj < 2; ++bj) { const f32x4 v0 = acc[ai][bj][m][0] * r, v1 = acc[ai][bj][m][1] * r;
                    u32x4 w; w.x = cvt_pk_bf16(v0[0], v0[1]); w.y = cvt_pk_bf16(v0[2], v0[3]); w.z = cvt_pk_bf16(v1[0], v1[1]); w.w = cvt_pk_bf16(v1[2], v1[3]);
                    *(u32x4*)(rowp + bj * HALF) = w; } }
    }
};
struct EpiResid {
    static constexpr bool PERM = true, AFTER_DRAIN = false;
    const float* base; float* out; bf16_t* xb; float* ssqp_out;
    __device__ __forceinline__ void operator()(const f32x4 (&acc)[2][2][4][2], const Unit& u, int wr, int wc, int fr, int fq) const {
        const int row0 = u.pm * BM + wr * 64 + fr, col0 = u.pn * BM + wc * 32 + 8 * fq;
#pragma unroll
        for (int ai = 0; ai < 2; ++ai)
#pragma unroll
            for (int m = 0; m < 4; ++m) { const int row = row0 + ai * HALF + m * 16; const size_t off = (size_t)row * 1024 + col0; float ss = 0.f;
#pragma unroll
                for (int bj = 0; bj < 2; ++bj) {
                    const f32x4 b0 = *(const f32x4*)(base + off + bj * HALF), b1 = *(const f32x4*)(base + off + bj * HALF + 4);
                    const f32x4 v0 = acc[ai][bj][m][0] + b0, v1 = acc[ai][bj][m][1] + b1;
                    *(f32x4*)(out + off + bj * HALF) = v0; *(f32x4*)(out + off + bj * HALF + 4) = v1;
                    u32x4 w; w.x = cvt_pk_bf16(v0[0], v0[1]); w.y = cvt_pk_bf16(v0[2], v0[3]); w.z = cvt_pk_bf16(v1[0], v1[1]); w.w = cvt_pk_bf16(v1[2], v1[3]);
                    *(u32x4*)(xb + off + bj * HALF) = w;
                    ss += (v0[0] * v0[0] + v0[1] * v0[1]) + (v0[2] * v0[2] + v0[3] * v0[3]) + (v1[0] * v1[0] + v1[1] * v1[1]) + (v1[2] * v1[2] + v1[3] * v1[3]); }
                ss += __shfl_xor(ss, 16); ss += __shfl_xor(ss, 32);
                if (fq == 0) ssqp_out[(size_t)row * 16 + u.pn * 4 + wc] = ss;
                if (m & 1) asm volatile("" ::: "memory"); }
    }
};
struct EpiSwiGLU {
    static constexpr bool PERM = true, AFTER_DRAIN = false;
    bf16_t* H; const float* ssqp;
    __device__ __forceinline__ void operator()(const f32x4 (&acc)[2][2][4][2], const Unit& u, int wr, int wc, int fr, int fq) const {
        const int row0 = u.pm * BM + wr * 64 + fr, hcol = u.pn * HALF + wc * 32 + 8 * fq;
#pragma unroll
        for (int ai = 0; ai < 2; ++ai)
#pragma unroll
            for (int m = 0; m < 4; ++m) { const int row = row0 + ai * HALF + m * 16; const float r = row_rscale(ssqp, row, fq);
                float hv[8];
#pragma unroll
                for (int n = 0; n < 2; ++n)
#pragma unroll
                    for (int j = 0; j < 4; ++j) { const float g = acc[ai][0][m][n][j] * r, up = acc[ai][1][m][n][j] * r;
                        const float sg = g * __builtin_amdgcn_rcpf(1.0f + __builtin_amdgcn_exp2f(-1.4426950408889634f * g)); hv[n * 4 + j] = sg * up; }
                u32x4 w; w.x = cvt_pk_bf16(hv[0], hv[1]); w.y = cvt_pk_bf16(hv[2], hv[3]); w.z = cvt_pk_bf16(hv[4], hv[5]); w.w = cvt_pk_bf16(hv[6], hv[7]);
                *(u32x4*)(H + (size_t)row * 2816 + hcol) = w; }
    }
};

template <class Epi, class Sched, bool ALIGN_EPI = false, bool SP2 = false>
__device__ __forceinline__ void gemm_phase(PG8_LAS unsigned char* lds, const Gemm g, const Sched& S, const Epi& E, const int tid) {
    const int wid = __builtin_amdgcn_readfirstlane(tid >> 6), lane = tid & 63, wr = wid >> 2, wc = wid & 3, fr = lane & 15, fq = lane >> 4;
    const int K = g.K, nt = K / BK;
    unsigned voffA[2], voffB[2];
#pragma unroll
    for (int i = 0; i < 2; ++i) { int R, C; stage_rc(tid * 16 + i * 8192, R, C); const int Rb = Epi::PERM ? ((R & ~31) + perm32(R & 31)) : R;
        voffA[i] = (unsigned)(R * K + C) * 2u; voffB[i] = (unsigned)(Rb * K + C) * 2u; }
    const size_t kstep = (size_t)(BK * 2);
    const size_t hstep = (size_t)HALF * K * 2;
    const size_t tstep = 2 * hstep;
    const unsigned ldsw = (unsigned)wid * 1024u;
    const int aoff = lds_byte(wr * 64 + fr, fq * 8), boff = lds_byte(wc * 32 + fr, fq * 8);
#define PG8_SA(b, h) (((b) * 2 + (h)) * HTB)
#define PG8_SB(b, h) ((4 + (b) * 2 + (h)) * HTB)
#define PG8_STAGE(bufoff, gbase, voff) do { _Pragma("unroll") for (int _i = 0; _i < 2; ++_i) \
        __builtin_amdgcn_global_load_lds((const unsigned*)((const char*)(gbase) + (voff)[_i]), (PG8_LAS unsigned*)(lds + (bufoff) + ldsw + _i * 8192), 16, 0, 0); } while (0)
#define PG8_LDA(dst, b, h) do { _Pragma("unroll") for (int m = 0; m < 4; ++m) _Pragma("unroll") for (int k = 0; k < 2; ++k) dst[m][k] = *(const PG8_LAS bf16x8*)(lds + PG8_SA(b, h) + aoff + m * 2048 + k * 1024); } while (0)
#define PG8_LDB(dst, b, h) do { _Pragma("unroll") for (int n = 0; n < 2; ++n) _Pragma("unroll") for (int k = 0; k < 2; ++k) dst[n][k] = *(const PG8_LAS bf16x8*)(lds + PG8_SB(b, h) + boff + n * 2048 + k * 1024); } while (0)
#define PG8_MMA(ai, bj, At, Bt) do { __builtin_amdgcn_s_setprio(1); _Pragma("unroll") for (int m = 0; m < 4; ++m) _Pragma("unroll") for (int n = 0; n < 2; ++n) _Pragma("unroll") for (int k = 0; k < 2; ++k) \
        acc[ai][bj][m][n] = __builtin_amdgcn_mfma_f32_16x16x32_bf16(Bt[n][k], At[m][k], acc[ai][bj][m][n], 0, 0, 0); __builtin_amdgcn_s_setprio(0); } while (0)
#define PG8_WAIT_V(n) asm volatile("s_waitcnt vmcnt(" #n ")" ::: "memory")
#define PG8_WAIT_L(n) asm volatile("s_waitcnt lgkmcnt(" #n ")" ::: "memory")
#define PG8_BAR __builtin_amdgcn_s_barrier()
#define PG8_SCHED __builtin_amdgcn_sched_barrier(0)
    Unit cur, nxt; int ui = 0;
    if (!S.next(0, cur)) return;
    f32x4 acc[2][2][4][2];
#pragma unroll
    for (int a = 0; a < 2; ++a)
#pragma unroll
        for (int b = 0; b < 2; ++b)
#pragma unroll
            for (int m = 0; m < 4; ++m)
#pragma unroll
                for (int n = 0; n < 2; ++n) acc[a][b][m][n] = (f32x4){0.f, 0.f, 0.f, 0.f};
    bf16x8 At[4][2], B0[2][2], B1[2][2];
    const char* cA = (const char*)g.A + (size_t)cur.pm * tstep; const char* cB = (const char*)g.Bt + (size_t)cur.pn * tstep;
    S.a_ready(cur);
    if constexpr (SP2) {
        PG8_STAGE(PG8_SB(0, 0), cB, voffB); PG8_STAGE(PG8_SB(0, 1), cB + hstep, voffB); PG8_STAGE(PG8_SA(0, 0), cA, voffA); PG8_STAGE(PG8_SA(0, 1), cA + hstep, voffA);
        if (wr == 1) PG8_BAR;
        PG8_WAIT_V(2); PG8_BAR;
        PG8_STAGE(PG8_SB(1, 0), cB + kstep, voffB); PG8_STAGE(PG8_SA(1, 0), cA + kstep, voffA); PG8_STAGE(PG8_SB(1, 1), cB + hstep + kstep, voffB);
        PG8_WAIT_V(6); PG8_BAR;
    } else {
        PG8_STAGE(PG8_SB(0, 0), cB, voffB); PG8_STAGE(PG8_SA(0, 0), cA, voffA); PG8_STAGE(PG8_SB(0, 1), cB + hstep, voffB); PG8_STAGE(PG8_SA(0, 1), cA + hstep, voffA);
        if (wr == 1) PG8_BAR;
        PG8_WAIT_V(4); PG8_BAR;
        PG8_STAGE(PG8_SB(1, 0), cB + kstep, voffB); PG8_STAGE(PG8_SA(1, 0), cA + kstep, voffA); PG8_STAGE(PG8_SB(1, 1), cB + hstep + kstep, voffB);
        PG8_WAIT_V(6); PG8_BAR;
    }
    for (;;) {
        const bool has_next = S.next(ui + 1, nxt);
        const char* nA = has_next ? (const char*)g.A + (size_t)nxt.pm * tstep : cA; const char* nB = has_next ? (const char*)g.Bt + (size_t)nxt.pn * tstep : cB;
        for (int t = 0; t < nt; t += 2) {
            const bool last = (t == nt - 2);
            const char* a1 = cA + (size_t)(t + 1) * kstep;
            const char* a2 = last ? nA : cA + (size_t)(t + 2) * kstep; const char* b2 = last ? nB : cB + (size_t)(t + 2) * kstep;
            const char* a3 = a2 + kstep; const char* b3 = b2 + kstep;
            if (last && has_next) S.a_ready(nxt);
            if constexpr (SP2) {
            PG8_LDB(B0, 0, 0); PG8_LDB(B1, 0, 1); PG8_SCHED; PG8_LDA(At, 0, 0); PG8_STAGE(PG8_SA(1, 1), a1 + hstep, voffA);
            PG8_WAIT_V(8); PG8_WAIT_L(0); PG8_BAR; PG8_MMA(0, 0, At, B0); PG8_MMA(0, 1, At, B1); PG8_BAR; PG8_SCHED;
            PG8_LDA(At, 0, 1); PG8_STAGE(PG8_SB(0, 0), b2, voffB); PG8_STAGE(PG8_SB(0, 1), b2 + hstep, voffB); PG8_STAGE(PG8_SA(0, 0), a2, voffA);
            PG8_WAIT_V(8); PG8_WAIT_L(0); PG8_BAR; PG8_MMA(1, 0, At, B0); PG8_MMA(1, 1, At, B1); PG8_BAR; PG8_SCHED;
            PG8_LDB(B0, 1, 0); PG8_LDB(B1, 1, 1); PG8_SCHED; PG8_LDA(At, 1, 0); PG8_STAGE(PG8_SA(0, 1), a2 + hstep, voffA);
            PG8_WAIT_V(8); PG8_WAIT_L(0); PG8_BAR; PG8_MMA(0, 0, At, B0); PG8_MMA(0, 1, At, B1); PG8_BAR; PG8_SCHED;
            PG8_LDA(At, 1, 1); PG8_STAGE(PG8_SB(1, 0), b3, voffB); PG8_STAGE(PG8_SB(1, 1), b3 + hstep, voffB); PG8_STAGE(PG8_SA(1, 0), a3, voffA);
            PG8_WAIT_V(8); PG8_WAIT_L(0); PG8_BAR; PG8_MMA(1, 0, At, B0); PG8_MMA(1, 1, At, B1); PG8_BAR; PG8_SCHED;
            } else {
            PG8_LDB(B0, 0, 0); PG8_SCHED; PG8_LDA(At, 0, 0); PG8_STAGE(PG8_SA(1, 1), a1 + hstep, voffA);
            PG8_WAIT_L(8); PG8_BAR; PG8_WAIT_L(0); PG8_MMA(0, 0, At, B0); PG8_BAR; PG8_SCHED;
            PG8_LDB(B1, 0, 1); PG8_STAGE(PG8_SB(0, 0), b2, voffB);
            PG8_BAR; PG8_WAIT_L(0); PG8_MMA(0, 1, At, B1); PG8_BAR;
            PG8_LDA(At, 0, 1); PG8_STAGE(PG8_SA(0, 0), a2, voffA);
            PG8_BAR; PG8_WAIT_L(0); PG8_MMA(1, 0, At, B0); PG8_BAR; PG8_SCHED;
            PG8_STAGE(PG8_SB(0, 1), b2 + hstep, voffB);
            PG8_WAIT_V(6); PG8_BAR; PG8_MMA(1, 1, At, B1); PG8_BAR;
            PG8_LDB(B0, 1, 0); PG8_SCHED; PG8_LDA(At, 1, 0); PG8_STAGE(PG8_SA(0, 1), a2 + hstep, voffA);
            PG8_WAIT_L(8); PG8_BAR; PG8_WAIT_L(0); PG8_MMA(0, 0, At, B0); PG8_BAR; PG8_SCHED;
            PG8_LDB(B1, 1, 1); PG8_STAGE(PG8_SB(1, 0), b3, voffB);
            PG8_BAR; PG8_WAIT_L(0); PG8_MMA(0, 1, At, B1); PG8_BAR;
            PG8_LDA(At, 1, 1); PG8_STAGE(PG8_SA(1, 0), a3, voffA);
            PG8_BAR; PG8_WAIT_L(0); PG8_MMA(1, 0, At, B0); PG8_BAR; PG8_SCHED;
            PG8_STAGE(PG8_SB(1, 1), b3 + hstep, voffB);
            PG8_WAIT_V(6); PG8_BAR; PG8_MMA(1, 1, At, B1); PG8_BAR;
            }
        }
        if constexpr (ALIGN_EPI) { if (wr == 0) PG8_BAR; }
        if constexpr (!Epi::AFTER_DRAIN) { E(acc, cur, wr, wc, fr, fq); S.done(cur); }
        if (!has_next) break;
#pragma unroll
        for (int a = 0; a < 2; ++a)
#pragma unroll
            for (int b = 0; b < 2; ++b)
#pragma unroll
                for (int m = 0; m < 4; ++m)
#pragma unroll
                    for (int n = 0; n < 2; ++n) acc[a][b][m][n] = (f32x4){0.f, 0.f, 0.f, 0.f};
        cur = nxt; cA = nA; cB = nB; ++ui;
        if constexpr (ALIGN_EPI) { if (wr == 1) PG8_BAR; }
    }
    PG8_WAIT_V(0);
    if constexpr (!ALIGN_EPI) { if (wr == 0) PG8_BAR; }
    PG8_BAR;
    if constexpr (Epi::AFTER_DRAIN) { E.fused(acc, cur, wr, wc, fr, fq, lds, wid, lane); S.done(cur); }
#undef PG8_SA
#undef PG8_SB
#undef PG8_STAGE
#undef PG8_LDA
#undef PG8_LDB
#undef PG8_MMA
#undef PG8_WAIT_V
#undef PG8_WAIT_L
#undef PG8_BAR
#undef PG8_SCHED
}
}
namespace att {
#define ATT_LAS __attribute__((address_space(3)))
typedef unsigned short bf16_t;
typedef short bf16x8 __attribute__((ext_vector_type(8)));
typedef short s16x4 __attribute__((ext_vector_type(4)));
typedef short v4i16_t __attribute__((ext_vector_type(4)));
typedef float f32x16 __attribute__((ext_vector_type(16)));
typedef float f32x4 __attribute__((ext_vector_type(4)));
typedef unsigned u32x4 __attribute__((ext_vector_type(4)));
typedef float f32x2_t __attribute__((ext_vector_type(2)));
typedef __bf16 bf16x2_t __attribute__((ext_vector_type(2)));
constexpr float NEGF = -1e30f, LOG2E = 1.4426950408889634f;
constexpr int TILE_B = 16384;
constexpr int WSF_OFF = 131072;

__device__ __forceinline__ int crow(int r, int hi) { return (r & 3) + 8 * (r >> 2) + 4 * hi; }
__device__ __forceinline__ unsigned cvtpk(float lo, float hi) { f32x2_t v = {lo, hi}; bf16x2_t b = __builtin_convertvector(v, bf16x2_t); return __builtin_bit_cast(unsigned, b); }
__device__ __forceinline__ s16x4 vtr(const ATT_LAS char* p) { return __builtin_bit_cast(s16x4, __builtin_amdgcn_ds_read_tr16_b64_v4i16((ATT_LAS v4i16_t*)p)); }
__device__ __forceinline__ float bf2f(unsigned short b) { return __builtin_bit_cast(float, (unsigned)b << 16); }

__device__ __forceinline__ void stage_write(ATT_LAS char* tile, int idx, u32x4 kv, u32x4 vv) {
    const int key = idx >> 3, ch = idx & 7;
    *(ATT_LAS u32x4*)(tile + ch * 1024 + key * 16) = kv;
    *(ATT_LAS u32x4*)(tile + 8192 + (ch >> 2) * 4096 + (key >> 4) * 1024 + (key & 15) * 64 + (ch & 3) * 16) = vv;
}

struct WS { f32x16 o0, o1; float m, l; };

__device__ __forceinline__ void tile_step(WS& s, const ATT_LAS char* tile, const bf16x8 (&qr)[4], float fd0, float slope2, float Wf, ATT_LAS float* wsf, int lane) {
    const int r32 = lane & 31, hi = lane >> 5;
    const ATT_LAS char* kb = tile + hi * 1024 + r32 * 16;
    f32x16 p0, p1;
#pragma unroll
    for (int r = 0; r < 16; ++r) { p0[r] = 0.f; p1[r] = 0.f; }
#pragma unroll
    for (int d0 = 0; d0 < 4; ++d0) {
        const bf16x8 b0 = *(const ATT_LAS bf16x8*)(kb + d0 * 2048), b1 = *(const ATT_LAS bf16x8*)(kb + d0 * 2048 + 512);
        p0 = __builtin_amdgcn_mfma_f32_32x32x16_bf16(b0, qr[d0], p0, 0, 0, 0);
        p1 = __builtin_amdgcn_mfma_f32_32x32x16_bf16(b1, qr[d0], p1, 0, 0, 0);
    }
    float mx = NEGF;
#pragma unroll
    for (int r = 0; r < 16; ++r) {
        const float c = (float)((r & 3) + 8 * (r >> 2));
        const float a0 = __builtin_fabsf(fd0 + c), a1 = __builtin_fabsf(fd0 + (c + 32.f));
        const float x0 = __builtin_fmaf(-slope2, a0, p0[r]), x1 = __builtin_fmaf(-slope2, a1, p1[r]);
        p0[r] = (a0 <= Wf) ? x0 : NEGF; p1[r] = (a1 <= Wf) ? x1 : NEGF;
        mx = __builtin_fmaxf(mx, __builtin_fmaxf(p0[r], p1[r]));
    }
    mx = __builtin_fmaxf(mx, __shfl_xor(mx, 32));
    const float mn = __builtin_fmaxf(s.m, mx);
    const float f = __builtin_amdgcn_exp2f(s.m - mn);
    s.m = mn;
    float ls = 0.f;
#pragma unroll
    for (int r = 0; r < 16; ++r) { p0[r] = __builtin_amdgcn_exp2f(p0[r] - mn); p1[r] = __builtin_amdgcn_exp2f(p1[r] - mn); ls += p0[r] + p1[r]; }
    s.l = s.l * f + ls;
    if (__any(f != 1.0f)) {
        if (hi == 0) wsf[r32] = f;
#pragma unroll
        for (int i = 0; i < 4; ++i) { const f32x4 fv = *(const ATT_LAS f32x4*)(wsf + 8 * i + 4 * hi);
#pragma unroll
            for (int j = 0; j < 4; ++j) { s.o0[4 * i + j] *= fv[j]; s.o1[4 * i + j] *= fv[j]; } }
    }
    u32x4 pw[4];
#pragma unroll
    for (int j = 0; j < 4; ++j) { pw[0][j] = cvtpk(p0[2 * j], p0[2 * j + 1]); pw[1][j] = cvtpk(p0[8 + 2 * j], p0[9 + 2 * j]); pw[2][j] = cvtpk(p1[2 * j], p1[2 * j + 1]); pw[3][j] = cvtpk(p1[8 + 2 * j], p1[9 + 2 * j]); }
    const ATT_LAS char* vb = tile + 8192 + ((lane >> 4) & 1) * 32 + (lane & 3) * 8 + (4 * hi + ((lane & 15) >> 2)) * 64;
#pragma unroll
    for (int ks = 0; ks < 4; ++ks) {
        const s16x4 l0 = vtr(vb + ks * 1024), h0 = vtr(vb + ks * 1024 + 512), l1 = vtr(vb + 4096 + ks * 1024), h1 = vtr(vb + 4096 + ks * 1024 + 512);
        const bf16x8 v0 = (bf16x8){l0[0], l0[1], l0[2], l0[3], h0[0], h0[1], h0[2], h0[3]}, v1 = (bf16x8){l1[0], l1[1], l1[2], l1[3], h1[0], h1[1], h1[2], h1[3]};
        const bf16x8 pa = __builtin_bit_cast(bf16x8, pw[ks]);
        s.o0 = __builtin_amdgcn_mfma_f32_32x32x16_bf16(pa, v0, s.o0, 0, 0, 0);
        s.o1 = __builtin_amdgcn_mfma_f32_32x32x16_bf16(pa, v1, s.o1, 0, 0, 0);
    }
}

__device__ __forceinline__ void store_o(const WS& s, float inv, bf16_t* orow0, size_t rstride, ATT_LAS float* wsf, int lane) {
    const int r32 = lane & 31, hi = lane >> 5;
    if (hi == 0) wsf[r32] = inv;
#pragma unroll
    for (int i = 0; i < 4; ++i) { const f32x4 fv = *(const ATT_LAS f32x4*)(wsf + 8 * i + 4 * hi);
#pragma unroll
        for (int j = 0; j < 4; ++j) { const int r = 4 * i + j; bf16_t* p = orow0 + (size_t)crow(r, hi) * rstride + r32;
            p[0] = (bf16_t)(cvtpk(s.o0[r] * fv[j], 0.f) & 0xffffu); p[32] = (bf16_t)(cvtpk(s.o1[r] * fv[j], 0.f) & 0xffffu); } }
}

__device__ __forceinline__ void attn_a_item(int item, const bf16_t* qkv  , bf16_t* O  , const float* sink, ATT_LAS char* lds, const int tid) {
    const int lane = tid & 63, wave = __builtin_amdgcn_readfirstlane(tid >> 6), r32 = lane & 31, hi = lane >> 5;
    const int qb = item & 31, kvh = (item >> 5) & 3, b = item >> 7;
    const int q0 = qb * 64, tok0 = b * 2048;
    ATT_LAS float* wsf = (ATT_LAS float*)(lds + WSF_OFF) + wave * 64;
    {
        u32x4 kr[5], vr[5];
#pragma unroll
        for (int j = 0; j < 5; ++j) { const int ks = q0 - 128 + 64 * j;
            if (ks >= 0 && ks < 2048) { const bf16_t* src = qkv + (size_t)(tok0 + ks + (tid >> 3)) * 1536 + 1024 + kvh * 64 + (tid & 7) * 8; kr[j] = *(const u32x4*)src; vr[j] = *(const u32x4*)(src + 256); } }
#pragma unroll
        for (int j = 0; j < 5; ++j) { const int ks = q0 - 128 + 64 * j; if (ks >= 0 && ks < 2048) stage_write(lds + j * TILE_B, tid, kr[j], vr[j]); }
    }
    const int g = wave & 3, half = wave >> 2, hq = kvh * 4 + g, qpos = q0 + 32 * half + r32;
    bf16x8 qr[4];
#pragma unroll
    for (int d0 = 0; d0 < 4; ++d0) qr[d0] = *(const bf16x8*)(qkv + (size_t)(tok0 + qpos) * 1536 + hq * 64 + d0 * 16 + hi * 8);
    const float slope2 = __builtin_amdgcn_exp2f(-0.5f * (float)(hq + 1)) * LOG2E;
    __syncthreads();
    WS s;
#pragma unroll
    for (int r = 0; r < 16; ++r) { s.o0[r] = 0.f; s.o1[r] = 0.f; }
    s.m = NEGF; s.l = 0.f;
    for (int j = 0; j < 5; ++j) { const int ks = q0 - 128 + 64 * j;
        if (ks >= 0 && ks < 2048) tile_step(s, lds + j * TILE_B, qr, (float)(ks - qpos + 4 * hi), slope2, 128.f, wsf, lane); }
    const float lt = s.l + __shfl_xor(s.l, 32);
    const float inv = 1.0f / (lt + __builtin_amdgcn_exp2f(sink[hq] * LOG2E - s.m));
    store_o(s, inv, O + (size_t)(tok0 + q0 + 32 * half) * 1024 + hq * 64, 1024, wsf, lane);
    __syncthreads();
}

__device__ __forceinline__ void attn_b_item(int item, int gi, int dil, const bf16_t* qkv  , bf16_t* O  , float* lse  , ATT_LAS char* lds, const int tid) {
    const int lane = tid & 63, wave = __builtin_amdgcn_readfirstlane(tid >> 6), r32 = lane & 31, hi = lane >> 5;
    const int hp = item & 7, within = (item >> 3) & 15, b = item >> 7;
    const int res = within % dil, qb = within / dil, L = 2048 / dil, u0 = qb * 128, tokb = b * 2048 + res;
    ATT_LAS float* wsf = (ATT_LAS float*)(lds + WSF_OFF) + wave * 64;
    {
        u32x4 kr[8], vr[8];
#pragma unroll
        for (int t = 0; t < 8; ++t) { const int j = t & 3, hh = t >> 2, ks = u0 - 64 + 64 * j;
            if (ks >= 0 && ks < L) { const bf16_t* src = qkv + (size_t)(tokb + (ks + (tid >> 3)) * dil) * 3072 + 1024 + (2 * hp + hh) * 64 + (tid & 7) * 8; kr[t] = *(const u32x4*)src; vr[t] = *(const u32x4*)(src + 1024); } }
#pragma unroll
        for (int t = 0; t < 8; ++t) { const int j = t & 3, ks = u0 - 64 + 64 * j; if (ks >= 0 && ks < L) stage_write(lds + t * TILE_B, tid, kr[t], vr[t]); }
    }
    const int hh = wave >> 2, wq = wave & 3, h = 2 * hp + hh, qpos = u0 + 32 * wq + r32;
    const size_t qtok = (size_t)(tokb + qpos * dil);
    bf16x8 qr[4];
#pragma unroll
    for (int d0 = 0; d0 < 4; ++d0) qr[d0] = *(const bf16x8*)(qkv + qtok * 3072 + h * 64 + d0 * 16 + hi * 8);
    const float slope2 = __builtin_amdgcn_exp2f(-0.5f * (float)(h + 1)) * LOG2E * (float)dil;
    bf16_t* orow0 = O + (size_t)(tokb + (u0 + 32 * wq) * dil) * 1024 + h * 64;
    const size_t rstride = (size_t)dil * 1024;
    WS s;
    if (gi == 0) {
#pragma unroll
        for (int r = 0; r < 16; ++r) { s.o0[r] = 0.f; s.o1[r] = 0.f; }
        s.m = NEGF; s.l = 0.f;
    } else {
        s.m = lse[qtok * 16 + h]; s.l = (hi == 0) ? 1.0f : 0.0f;
#pragma unroll
        for (int r = 0; r < 16; ++r) { const bf16_t* p = orow0 + (size_t)crow(r, hi) * rstride + r32; s.o0[r] = bf2f(p[0]); s.o1[r] = bf2f(p[32]); }
    }
    __syncthreads();
    for (int jj = 0; jj < 3; ++jj) { const int j = (wq >> 1) + jj, ks = u0 - 64 + 64 * j;
        if (ks >= 0 && ks < L) tile_step(s, lds + (hh * 4 + j) * TILE_B, qr, (float)(ks - qpos + 4 * hi), slope2, 64.f, wsf, lane); }
    const float lt = s.l + __shfl_xor(s.l, 32);
    if (hi == 0) lse[qtok * 16 + h] = s.m + __builtin_log2f(lt);
    store_o(s, 1.0f / lt, orow0, rstride, wsf, lane);
    __syncthreads();
}
}

#ifndef MK_MULTI
#define MK_MULTI 0
#endif
#define LAS __attribute__((address_space(3)))
typedef unsigned short bf16;
typedef unsigned v4u __attribute__((ext_vector_type(4)));
typedef float f32x4 __attribute__((ext_vector_type(4)));
constexpr int NWAVES = 8, T = 16 * 2048, D = 1024, FF = 2816, NPH = 16;
constexpr size_t MiB = 1u << 20;
constexpr size_t WS_SSQ = 0, WS_LSE = 2 * MiB;
constexpr size_t WS_WQKVA = 4 * MiB, WS_WOA = 7 * MiB, WS_WGU0 = 9 * MiB, WS_WD0 = 20 * MiB, WS_WQKVB = 26 * MiB, WS_WOB = 44 * MiB, WS_WGU1 = 46 * MiB, WS_WD1 = 57 * MiB;
constexpr size_t WS_XB = 64 * MiB, WS_O = 128 * MiB, WS_BIG = 192 * MiB, WS_END = 384 * MiB;
constexpr int LDS_BYTES = 147456;

__device__ __forceinline__ unsigned f2bf(float f) { unsigned u = __builtin_bit_cast(unsigned, f); return (u + 0x7fffu + ((u >> 16) & 1u)) >> 16; }
__device__ __forceinline__ unsigned pk2(float lo, float hi) { return f2bf(lo) | (f2bf(hi) << 16); }
__device__ __forceinline__ float wave_sum(float v) {
#pragma unroll
    for (int o = 1; o < 64; o <<= 1) v += __shfl_xor(v, o);
    return v;
}
__device__ __forceinline__ void transpose_item(const float* W, int K, int N, bf16* WT, const float* gs, int mode, LAS float* scr, int item, int lane) {
    const int nblk = N / 32, kb = item / nblk, nb = item % nblk, k0 = 64 * kb, n0 = 32 * nb;
#pragma unroll 8
    for (int i = 0; i < 32; ++i) { const int kk = 2 * i + (lane >> 5); const float sc = gs ? gs[k0 + kk] : 1.0f; scr[kk * 33 + (lane & 31)] = W[(size_t)(k0 + kk) * N + n0 + (lane & 31)] * sc; }
    asm volatile("s_waitcnt lgkmcnt(0)" ::: "memory");
    const int c = lane & 7;
    const int rbase = (mode == 0) ? n0 : (256 * (n0 >> 7) + (n0 & 127) + (mode == 2 ? 128 : 0));
#pragma unroll
    for (int j = 0; j < 4; ++j) { const int n = (lane >> 3) + 8 * j; const LAS float* s = scr + (8 * c) * 33 + n;
        v4u o; o.x = pk2(s[0 * 33], s[1 * 33]); o.y = pk2(s[2 * 33], s[3 * 33]); o.z = pk2(s[4 * 33], s[5 * 33]); o.w = pk2(s[6 * 33], s[7 * 33]);
        *(v4u*)(WT + (size_t)(rbase + n) * K + k0 + 8 * c) = o; }
    asm volatile("s_waitcnt lgkmcnt(0)" ::: "memory");
}

struct Args { const float* in[12]; float* out; unsigned char* ws; int ph_lo, ph_hi; };

__global__ void __launch_bounds__(NWAVES * 64, 2) fwd_megakernel(Args a) {
    extern __shared__ __attribute__((aligned(16))) unsigned char lds_raw[];
    LAS unsigned char* lds = (LAS unsigned char*)lds_raw;
    cg::grid_group grid = cg::this_grid();
    const int G = gridDim.x, bid = blockIdx.x;
    unsigned char* ws = a.ws;
    float* ssqp = (float*)(ws + WS_SSQ); float* lse = (float*)(ws + WS_LSE);
    bf16* XB = (bf16*)(ws + WS_XB); bf16* OB = (bf16*)(ws + WS_O); bf16* BIG = (bf16*)(ws + WS_BIG);
    const int NGW = G * NWAVES;

    for (int ph = a.ph_lo; ph < a.ph_hi; ++ph) {
        int tid = threadIdx.x; asm volatile("" : "+v"(tid));
        const int lane = tid & 63, wave = __builtin_amdgcn_readfirstlane(tid >> 6), gw = bid * NWAVES + wave;
        if (ph == 0) {
            LAS float* scr = (LAS float*)(lds + wave * 16384);
            constexpr int I_QA = 16 * 48, I_O = 16 * 32, I_G = 16 * 88, I_D = 44 * 32, I_QB = 16 * 288;
            constexpr int NITEMS = I_QA + 2 * I_O + 4 * I_G + 2 * I_D + I_QB;
            for (int it = gw; it < NITEMS; it += NGW) {
                int r = it;
                if (r < I_QA) { transpose_item(a.in[3], D, 1536, (bf16*)(ws + WS_WQKVA), a.in[1], 0, scr, r, lane); continue; } r -= I_QA;
                if (r < I_O) { transpose_item(a.in[4], D, D, (bf16*)(ws + WS_WOA), nullptr, 0, scr, r, lane); continue; } r -= I_O;
                if (r < I_O) { transpose_item(a.in[7], D, D, (bf16*)(ws + WS_WOB), nullptr, 0, scr, r, lane); continue; } r -= I_O;
                if (r < I_G) { transpose_item(a.in[8], D, FF, (bf16*)(ws + WS_WGU0), a.in[2], 1, scr, r, lane); continue; } r -= I_G;
                if (r < I_G) { transpose_item(a.in[9], D, FF, (bf16*)(ws + WS_WGU0), a.in[2], 2, scr, r, lane); continue; } r -= I_G;
                if (r < I_G) { transpose_item(a.in[8] + (size_t)D * FF, D, FF, (bf16*)(ws + WS_WGU1), a.in[2] + D, 1, scr, r, lane); continue; } r -= I_G;
                if (r < I_G) { transpose_item(a.in[9] + (size_t)D * FF, D, FF, (bf16*)(ws + WS_WGU1), a.in[2] + D, 2, scr, r, lane); continue; } r -= I_G;
                if (r < I_D) { transpose_item(a.in[10], FF, D, (bf16*)(ws + WS_WD0), nullptr, 0, scr, r, lane); continue; } r -= I_D;
                if (r < I_D) { transpose_item(a.in[10] + (size_t)FF * D, FF, D, (bf16*)(ws + WS_WD1), nullptr, 0, scr, r, lane); continue; } r -= I_D;
                transpose_item(a.in[6], D, 9216, (bf16*)(ws + WS_WQKVB), a.in[1] + D, 0, scr, r, lane);
            }
            for (int m = gw; m < T; m += NGW) {
                const f32x4* xr = (const f32x4*)(a.in[0] + (size_t)m * D) + lane;
                f32x4 v[4]; float s = 0.f;
#pragma unroll
                for (int j = 0; j < 4; ++j) { v[j] = xr[64 * j]; s += (v[j].x * v[j].x + v[j].y * v[j].y) + (v[j].z * v[j].z + v[j].w * v[j].w); }
                s = wave_sum(s);
                unsigned long long* o8 = (unsigned long long*)(XB + (size_t)m * D) + lane;
#pragma unroll
                for (int j = 0; j < 4; ++j) o8[64 * j] = (unsigned long long)pk2(v[j].x, v[j].y) | ((unsigned long long)pk2(v[j].z, v[j].w) << 32);
                if (lane < 16) ssqp[(size_t)m * 16 + lane] = (lane == 0) ? s : 0.f;
            }
            __syncthreads();
        } else if (ph == 1 || ph == 6 || ph == 8 || ph == 10) {
            const int gi = (ph - 6) >> 1;
            const int N = (ph == 1) ? 1536 : 3072;
            const bf16* Bt = (ph == 1) ? (const bf16*)(ws + WS_WQKVA) : (const bf16*)(ws + WS_WQKVB) + (size_t)gi * 3072 * D;
            pg8::Gemm g{XB, Bt, T, N, D}; pg8::StaticOrder S; S.init(T, N, G, bid);
            pg8::EpiQKV E{BIG, N, ssqp, 4};
#ifndef DIS_QKV
            pg8::gemm_phase<pg8::EpiQKV, pg8::StaticOrder, true, true>(lds, g, S, E, tid);
#endif
        } else if (ph == 2) {
#ifndef DIS_ATTA
            for (int it = bid; it < 2048; it += G) att::attn_a_item(it, BIG, OB, a.in[5], (LAS char*)lds, tid);
#endif
        } else if (ph == 7 || ph == 9 || ph == 11) {
            const int gi = (ph - 7) >> 1, dil = (gi == 0) ? 1 : (gi == 1 ? 4 : 16);
#ifndef DIS_ATTB
            for (int it = bid; it < 2048; it += G) att::attn_b_item(it, gi, dil, BIG, OB, lse, (LAS char*)lds, tid);
#endif
        } else if (ph == 3 || ph == 5 || ph == 12 || ph == 14) {
            const bool down = (ph == 5 || ph == 14);
            const bf16* A = down ? BIG : OB;
            const bf16* Bt = (const bf16*)(ws + (ph == 3 ? WS_WOA : ph == 5 ? WS_WD0 : ph == 12 ? WS_WOB : WS_WD1));
            pg8::Gemm g{A, Bt, T, D, down ? FF : D}; pg8::StaticOrder S; S.init(T, D, G, bid);
            pg8::EpiResid E{(ph == 3) ? a.in[0] : a.out, a.out, XB, ssqp};
#ifndef DIS_RES
            pg8::gemm_phase<pg8::EpiResid, pg8::StaticOrder, true, true>(lds, g, S, E, tid);
#endif
        } else if (ph == 4 || ph == 13) {
            const bf16* Bt = (const bf16*)(ws + (ph == 4 ? WS_WGU0 : WS_WGU1));
            pg8::Gemm g{XB, Bt, T, 2 * FF, D}; pg8::StaticOrder S; S.init(T, 2 * FF, G, bid);
            pg8::EpiSwiGLU E{BIG, ssqp};
#ifndef DIS_SWI
            pg8::gemm_phase<pg8::EpiSwiGLU, pg8::StaticOrder, true, true>(lds, g, S, E, tid);
#endif
        } else {
            const float* gf = a.in[11];
            for (int m = gw; m < T; m += NGW) {
                float s = (lane < 16) ? ssqp[(size_t)m * 16 + lane] : 0.f;
                s = wave_sum(s);
                const float r = rsqrtf(s * (1.0f / 1024.0f) + 1e-6f);
                f32x4* xr = (f32x4*)(a.out + (size_t)m * D) + lane;
#pragma unroll
                for (int j = 0; j < 4; ++j) { const f32x4 gv = ((const f32x4*)gf)[lane + 64 * j]; f32x4 v = xr[64 * j]; v = v * r * gv; xr[64 * j] = v; }
            }
        }
        if (ph + 1 < a.ph_hi) { __threadfence(); grid.sync(); __builtin_amdgcn_fence(__ATOMIC_ACQUIRE, "agent"); }
    }
}

extern "C" void kernel_launch(void* const* d_in, const int* in_sizes, int n_in, void* d_out, int out_size, void* d_ws, size_t ws_size, hipStream_t stream) {
    static int grid = 0;
    if (grid == 0) {
        int dev = 0, cus = 0, per_cu = 0;
        if (n_in != 12 || out_size != T * D || ws_size < WS_END) { fprintf(stderr, "kernel_launch: unexpected shapes (n_in %d out %d ws %zu)\n", n_in, out_size, ws_size); grid = -1; return; }
        hipGetDevice(&dev);
        hipDeviceGetAttribute(&cus, hipDeviceAttributeMultiprocessorCount, dev);
        if (hipFuncSetAttribute((const void*)fwd_megakernel, hipFuncAttributeMaxDynamicSharedMemorySize, LDS_BYTES) != hipSuccess) { fprintf(stderr, "kernel_launch: hipFuncSetAttribute failed\n"); grid = -1; return; }
        if (hipOccupancyMaxActiveBlocksPerMultiprocessor(&per_cu, (const void*)fwd_megakernel, NWAVES * 64, LDS_BYTES) != hipSuccess || per_cu < 1) { fprintf(stderr, "kernel_launch: occupancy query says %d\n", per_cu); per_cu = 1; }
        (void)hipGetLastError();
        grid = cus;
        fprintf(stderr, "kernel_launch: grid %d (per_cu %d)\n", grid, per_cu);
    }
    if (grid < 0) return;
    Args a{};
    for (int i = 0; i < 12; ++i) a.in[i] = (const float*)d_in[i];
    a.out = (float*)d_out; a.ws = (unsigned char*)d_ws;
#if MK_MULTI
    for (int ph = 0; ph < NPH; ++ph) {
        a.ph_lo = ph; a.ph_hi = ph + 1;
        void* args[] = {&a};
        hipError_t e = hipLaunchCooperativeKernel((const void*)fwd_megakernel, dim3(grid), dim3(NWAVES * 64), args, LDS_BYTES, stream);
        if (e != hipSuccess) { fprintf(stderr, "launch %d failed: %s\n", ph, hipGetErrorString(e)); break; }
    }
#else
    a.ph_lo = 0; a.ph_hi = NPH;
    void* args[] = {&a};
    hipError_t e = hipLaunchCooperativeKernel((const void*)fwd_megakernel, dim3(grid), dim3(NWAVES * 64), args, LDS_BYTES, stream);
    if (e != hipSuccess) fprintf(stderr, "cooperative launch failed: %s (grid %d)\n", hipGetErrorString(e), grid);
#endif
}
```

```cpp
#include <hip/hip_runtime.h>
#include <hip/hip_cooperative_groups.h>
#include <cstdio>
#include <cstdint>
namespace cg = cooperative_groups;
namespace pg8 {
#define PG8_LAS __attribute__((address_space(3)))
typedef unsigned short bf16_t;
typedef short bf16x8 __attribute__((ext_vector_type(8)));
typedef float f32x4 __attribute__((ext_vector_type(4)));
typedef unsigned u32x4 __attribute__((ext_vector_type(4)));
constexpr int BM = 256, BK = 64, HALF = 128, HTB = HALF * BK * 2  , STAGE_BYTES = 8 * HTB, NXCD = 8, WGM = 8;

__host__ __device__ __forceinline__ int lds_byte(int r, int c) { const int st = (r >> 4) * 2 + (c >> 5), rr = r & 15, cc = c & 31, ob = rr * 64 + cc * 2; return st * 1024 + (ob ^ (((ob >> 9) & 1) << 5)); }
__host__ __device__ __forceinline__ void stage_rc(int b, int& R, int& C) { const int st = b / 1024, sb = b % 1024, swz = sb ^ (((sb >> 9) & 1) << 5); R = (st >> 1) * 16 + swz / 64; C = (st & 1) * 32 + (swz % 64) / 2; }
__host__ __device__ __forceinline__ int perm32(int rho) { const int n = rho >> 4, i = rho & 15; return 8 * (i >> 2) + 4 * n + (i & 3); }

struct Unit { int pm, pn; };
struct Gemm { const bf16_t* A; const bf16_t* Bt; int M, N, K; };

struct StaticOrder {
    int nM, nN, nwg, G, c;
    __host__ __device__ void init(int M, int N, int G_, int c_) { nM = M / BM; nN = N / BM; nwg = nM * nN; G = G_; c = c_; }
    __host__ __device__ bool next(int i, Unit& u) const {
        const long L = (long)i * G + c; if (L >= nwg) return false;
        int wgid = (int)L; { const int q = nwg / NXCD, r = nwg % NXCD, xcd = wgid % NXCD, off = wgid / NXCD; wgid = (xcd < r ? xcd * (q + 1) : r * (q + 1) + (xcd - r) * q) + off; }
        const int nig = WGM * nN, gid = wgid / nig, fm = gid * WGM, gsz = (nM - fm) < WGM ? (nM - fm) : WGM;
        u.pm = fm + ((wgid % nig) % gsz); u.pn = (wgid % nig) / gsz; return true;
    }
    __device__ __forceinline__ void a_ready(const Unit&) const {}
    __device__ __forceinline__ void done(const Unit&) const {}
};

__device__ __forceinline__ unsigned cvt_pk_bf16(float lo, float hi) { unsigned r; asm volatile("v_cvt_pk_bf16_f32 %0, %1, %2" : "=v"(r) : "v"(lo), "v"(hi)); return r; }
constexpr float RMS_EPS_F = 1e-6f;
constexpr float QK_C2 = 0.125f * 1.4426950408889634f;
__device__ __forceinline__ float row_rscale(const float* ssqp, int row, int fq) {
    const f32x4 p = *(const f32x4*)(ssqp + (size_t)row * 16 + 4 * fq);
    float s = (p[0] + p[1]) + (p[2] + p[3]);
    s += __shfl_xor(s, 16); s += __shfl_xor(s, 32);
    return rsqrtf(s * (1.0f / 1024.0f) + RMS_EPS_F);
}
struct EpiQKV {
    static constexpr bool PERM = true, AFTER_DRAIN = false;
    bf16_t* O; int ldc; const float* ssqp; int qtiles;
    __device__ __forceinline__ void operator()(const f32x4 (&acc)[2][2][4][2], const Unit& u, int wr, int wc, int fr, int fq) const {
        const int row0 = u.pm * BM + wr * 64 + fr, col0 = u.pn * BM + wc * 32 + 8 * fq;
        const float sc = (u.pn < qtiles) ? QK_C2 : 1.0f;
#pragma unroll
        for (int ai = 0; ai < 2; ++ai)
#pragma unroll
            for (int m = 0; m < 4; ++m) { const int row = row0 + ai * HALF + m * 16; const float r = row_rscale(ssqp, row, fq) * sc;
                bf16_t* rowp = O + (size_t)row * ldc + col0;
#pragma unroll
                for (int bj = 0; bj < 2; ++bj) { const f32x4 v0 = acc[ai][bj][m][0] * r, v1 = acc[ai][bj][m][1] * r;
                    u32x4 w; w.x = cvt_pk_bf16(v0[0], v0[1]); w.y = cvt_pk_bf16(v0[2], v0[3]); w.z = cvt_pk_bf16(v1[0], v1[1]); w.w = cvt_pk_bf16(v1[2], v1[3]);
                    *(u32x4*)(rowp + bj * HALF) = w; } }
    }
};
struct EpiResid {
    static constexpr bool PERM = true, AFTER_DRAIN = false;
    const float* base; float* out; bf16_t* xb; float* ssqp_out;
    __device__ __forceinline__ void operator()(const f32x4 (&acc)[2][2][4][2], const Unit& u, int wr, int wc, int fr, int fq) const {
        const int row0 = u.pm * BM + wr * 64 + fr, col0 = u.pn * BM + wc * 32 + 8 * fq;
#pragma unroll
        for (int ai = 0; ai < 2; ++ai)
#pragma unroll
            for (int m = 0; m < 4; ++m) { const int row = row0 + ai * HALF + m * 16; const size_t off = (size_t)row * 1024 + col0; float ss = 0.f;
#pragma unroll
                for (int bj = 0; bj < 2; ++bj) {
                    const f32x4 b0 = *(const f32x4*)(base + off + bj * HALF), b1 = *(const f32x4*)(base + off + bj * HALF + 4);
                    const f32x4 v0 = acc[ai][bj][m][0] + b0, v1 = acc[ai][bj][m][1] + b1;
                    *(f32x4*)(out + off + bj * HALF) = v0; *(f32x4*)(out + off + bj * HALF + 4) = v1;
                    u32x4 w; w.x = cvt_pk_bf16(v0[0], v0[1]); w.y = cvt_pk_bf16(v0[2], v0[3]); w.z = cvt_pk_bf16(v1[0], v1[1]); w.w = cvt_pk_bf16(v1[2], v1[3]);
                    *(u32x4*)(xb + off + bj * HALF) = w;
                    ss += (v0[0] * v0[0] + v0[1] * v0[1]) + (v0[2] * v0[2] + v0[3] * v0[3]) + (v1[0] * v1[0] + v1[1] * v1[1]) + (v1[2] * v1[2] + v1[3] * v1[3]); }
                ss += __shfl_xor(ss, 16); ss += __shfl_xor(ss, 32);
                if (fq == 0) ssqp_out[(size_t)row * 16 + u.pn * 4 + wc] = ss;
                if (m & 1) asm volatile("" ::: "memory"); }
    }
};
struct EpiSwiGLU {
    static constexpr bool PERM = true, AFTER_DRAIN = false;
    bf16_t* H; const float* ssqp;
    __device__ __forceinline__ void operator()(const f32x4 (&acc)[2][2][4][2], const Unit& u, int wr, int wc, int fr, int fq) const {
        const int row0 = u.pm * BM + wr * 64 + fr, hcol = u.pn * HALF + wc * 32 + 8 * fq;
#pragma unroll
        for (int ai = 0; ai < 2; ++ai)
#pragma unroll
            for (int m = 0; m < 4; ++m) { const int row = row0 + ai * HALF + m * 16; const float r = row_rscale(ssqp, row, fq);
                float hv[8];
#pragma unroll
                for (int n = 0; n < 2; ++n)
#pragma unroll
                    for (int j = 0; j < 4; ++j) { const float g = acc[ai][0][m][n][j] * r, up = acc[ai][1][m][n][j] * r;
                        const float sg = g * __builtin_amdgcn_rcpf(1.0f + __builtin_amdgcn_exp2f(-1.4426950408889634f * g)); hv[n * 4 + j] = sg * up; }
                u32x4 w; w.x = cvt_pk_bf16(hv[0], hv[1]); w.y = cvt_pk_bf16(hv[2], hv[3]); w.z = cvt_pk_bf16(hv[4], hv[5]); w.w = cvt_pk_bf16(hv[6], hv[7]);
                *(u32x4*)(H + (size_t)row * 2816 + hcol) = w; }
    }
};

template <class Epi, class Sched, bool ALIGN_EPI = false, bool SP2 = false>
__device__ __forceinline__ void gemm_phase(PG8_LAS unsigned char* lds, const Gemm g, const Sched& S, const Epi& E, const int tid) {
    const int wid = __builtin_amdgcn_readfirstlane(tid >> 6), lane = tid & 63, wr = wid >> 2, wc = wid & 3, fr = lane & 15, fq = lane >> 4;
    const int K = g.K, nt = K / BK;
    unsigned voffA[2], voffB[2];
#pragma unroll
    for (int i = 0; i < 2; ++i) { int R, C; stage_rc(tid * 16 + i * 8192, R, C); const int Rb = Epi::PERM ? ((R & ~31) + perm32(R & 31)) : R;
        voffA[i] = (unsigned)(R * K + C) * 2u; voffB[i] = (unsigned)(Rb * K + C) * 2u; }
    const size_t kstep = (size_t)(BK * 2);
    const size_t hstep = (size_t)HALF * K * 2;
    const size_t tstep = 2 * hstep;
    const unsigned ldsw = (unsigned)wid * 1024u;
    const int aoff = lds_byte(wr * 64 + fr, fq * 8), boff = lds_byte(wc * 32 + fr, fq * 8);
#define PG8_SA(b, h) (((b) * 2 + (h)) * HTB)
#define PG8_SB(b, h) ((4 + (b) * 2 + (h)) * HTB)
#define PG8_STAGE(bufoff, gbase, voff) do { _Pragma("unroll") for (int _i = 0; _i < 2; ++_i) \
        __builtin_amdgcn_global_load_lds((const unsigned*)((const char*)(gbase) + (voff)[_i]), (PG8_LAS unsigned*)(lds + (bufoff) + ldsw + _i * 8192), 16, 0, 0); } while (0)
#define PG8_LDA(dst, b, h) do { _Pragma("unroll") for (int m = 0; m < 4; ++m) _Pragma("unroll") for (int k = 0; k < 2; ++k) dst[m][k] = *(const PG8_LAS bf16x8*)(lds + PG8_SA(b, h) + aoff + m * 2048 + k * 1024); } while (0)
#define PG8_LDB(dst, b, h) do { _Pragma("unroll") for (int n = 0; n < 2; ++n) _Pragma("unroll") for (int k = 0; k < 2; ++k) dst[n][k] = *(const PG8_LAS bf16x8*)(lds + PG8_SB(b, h) + boff + n * 2048 + k * 1024); } while (0)
#define PG8_MMA(ai, bj, At, Bt) do { __builtin_amdgcn_s_setprio(1); _Pragma("unroll") for (int m = 0; m < 4; ++m) _Pragma("unroll") for (int n = 0; n < 2; ++n) _Pragma("unroll") for (int k = 0; k < 2; ++k) \
        acc[ai][bj][m][n] = __builtin_amdgcn_mfma_f32_16x16x32_bf16(Bt[n][k], At[m][k], acc[ai][bj][m][n], 0, 0, 0); __builtin_amdgcn_s_setprio(0); } while (0)
#define PG8_WAIT_V(n) asm volatile("s_waitcnt vmcnt(" #n ")" ::: "memory")
#define PG8_WAIT_L(n) asm volatile("s_waitcnt lgkmcnt(" #n ")" ::: "memory")
#define PG8_BAR __builtin_amdgcn_s_barrier()
#define PG8_SCHED __builtin_amdgcn_sched_barrier(0)
    Unit cur, nxt; int ui = 0;
    if (!S.next(0, cur)) return;
    f32x4 acc[2][2][4][2];
#pragma unroll
    for (int a = 0; a < 2; ++a)
#pragma unroll
        for (int b = 0; b < 2; ++b)
#pragma unroll
            for (int m = 0; m < 4; ++m)
#pragma unroll
                for (int n = 0; n < 2; ++n) acc[a][b][m][n] = (f32x4){0.f, 0.f, 0.f, 0.f};
    bf16x8 At[4][2], B0[2][2], B1[2][2];
    const char* cA = (const char*)g.A + (size_t)cur.pm * tstep; const char* cB = (const char*)g.Bt + (size_t)cur.pn * tstep;
    S.a_ready(cur);
    if constexpr (SP2) {
        PG8_STAGE(PG8_SB(0, 0), cB, voffB); PG8_STAGE(PG8_SB(0, 1), cB + hstep, voffB); PG8_STAGE(PG8_SA(0, 0), cA, voffA); PG8_STAGE(PG8_SA(0, 1), cA + hstep, voffA);
        if (wr == 1) PG8_BAR;
        PG8_WAIT_V(2); PG8_BAR;
        PG8_STAGE(PG8_SB(1, 0), cB + kstep, voffB); PG8_STAGE(PG8_SA(1, 0), cA + kstep, voffA); PG8_STAGE(PG8_SB(1, 1), cB + hstep + kstep, voffB);
        PG8_WAIT_V(6); PG8_BAR;
    } else {
        PG8_STAGE(PG8_SB(0, 0), cB, voffB); PG8_STAGE(PG8_SA(0, 0), cA, voffA); PG8_STAGE(PG8_SB(0, 1), cB + hstep, voffB); PG8_STAGE(PG8_SA(0, 1), cA + hstep, voffA);
        if (wr == 1) PG8_BAR;
        PG8_WAIT_V(4); PG8_BAR;
        PG8_STAGE(PG8_SB(1, 0), cB + kstep, voffB); PG8_STAGE(PG8_SA(1, 0), cA + kstep, voffA); PG8_STAGE(PG8_SB(1, 1), cB + hstep + kstep, voffB);
        PG8_WAIT_V(6); PG8_BAR;
    }
    for (;;) {
        const bool has_next = S.next(ui + 1, nxt);
        const char* nA = has_next ? (const char*)g.A + (size_t)nxt.pm * tstep : cA; const char* nB = has_next ? (const char*)g.Bt + (size_t)nxt.pn * tstep : cB;
        for (int t = 0; t < nt; t += 2) {
            const bool last = (t == nt - 2);
            const char* a1 = cA + (size_t)(t + 1) * kstep;
            const char* a2 = last ? nA : cA + (size_t)(t + 2) * kstep; const char* b2 = last ? nB : cB + (size_t)(t + 2) * kstep;
            const char* a3 = a2 + kstep; const char* b3 = b2 + kstep;
            if (last && has_next) S.a_ready(nxt);
            if constexpr (SP2) {
            PG8_LDB(B0, 0, 0); PG8_LDB(B1, 0, 1); PG8_SCHED; PG8_LDA(At, 0, 0); PG8_STAGE(PG8_SA(1, 1), a1 + hstep, voffA);
            PG8_WAIT_V(8); PG8_WAIT_L(0); PG8_BAR; PG8_MMA(0, 0, At, B0); PG8_MMA(0, 1, At, B1); PG8_BAR; PG8_SCHED;
            PG8_LDA(At, 0, 1); PG8_STAGE(PG8_SB(0, 0), b2, voffB); PG8_STAGE(PG8_SB(0, 1), b2 + hstep, voffB); PG8_STAGE(PG8_SA(0, 0), a2, voffA);
            PG8_WAIT_V(8); PG8_WAIT_L(0); PG8_BAR; PG8_MMA(1, 0, At, B0); PG8_MMA(1, 1, At, B1); PG8_BAR; PG8_SCHED;
            PG8_LDB(B0, 1, 0); PG8_LDB(B1, 1, 1); PG8_SCHED; PG8_LDA(At, 1, 0); PG8_STAGE(PG8_SA(0, 1), a2 + hstep, voffA);
            PG8_WAIT_V(8); PG8_WAIT_L(0); PG8_BAR; PG8_MMA(0, 0, At, B0); PG8_MMA(0, 1, At, B1); PG8_BAR; PG8_SCHED;
            PG8_LDA(At, 1, 1); PG8_STAGE(PG8_SB(1, 0), b3, voffB); PG8_STAGE(PG8_SB(1, 1), b3 + hstep, voffB); PG8_STAGE(PG8_SA(1, 0), a3, voffA);
            PG8_WAIT_V(8); PG8_WAIT_L(0); PG8_BAR; PG8_MMA(1, 0, At, B0); PG8_MMA(1, 1, At, B1); PG8_BAR; PG8_SCHED;
            } else {
            PG8_LDB(B0, 0, 0); PG8_SCHED; PG8_LDA(At, 0, 0); PG8_STAGE(PG8_SA(1, 1), a1 + hstep, voffA);
            PG8_WAIT_L(8); PG8_BAR; PG8_WAIT_L(0); PG8_MMA(0, 0, At, B0); PG8_BAR; PG8_SCHED;
            PG8_LDB(B1, 0, 1); PG8_STAGE(PG8_SB(0, 0), b2, voffB);
            PG8_BAR; PG8_WAIT_L(0); PG8_MMA(0, 1, At, B1); PG8_BAR;
            PG8_LDA(At, 0, 1); PG8_STAGE(PG8_SA(0, 0), a2, voffA);
            PG8_BAR; PG8_WAIT_L(0); PG8_MMA(1, 0, At, B0); PG8_BAR; PG8_SCHED;
            PG8_STAGE(PG8_SB(0, 1), b2 + hstep, voffB);
            PG8_WAIT_V(6); PG8_BAR; PG8_MMA(1, 1, At, B1); PG8_BAR;
            PG8_LDB(B0, 1, 0); PG8_SCHED; PG8_LDA(At, 1, 0); PG8_STAGE(PG8_SA(0, 1), a2 + hstep, voffA);
            PG8_WAIT_L(8); PG8_BAR; PG8_WAIT_L(0); PG8_MMA(0, 0, At, B0); PG8_BAR; PG8_SCHED;
            PG8_LDB(B1, 1, 1); PG8_STAGE(PG8_SB(1, 0), b3, voffB);
            PG8_BAR; PG8_WAIT_L(0); PG8_MMA(0, 1, At, B1); PG8_BAR;
            PG8_LDA(At, 1, 1); PG8_STAGE(PG8_SA(1, 0), a3, voffA);
            PG8_BAR; PG8_WAIT_L(0); PG8_MMA(1, 0, At, B0); PG8_BAR; PG8_SCHED;
            PG8_STAGE(PG8_SB(1, 1), b3 + hstep, voffB);
            PG8_WAIT_V(6); PG8_BAR; PG8_MMA(1, 1, At, B1); PG8_BAR;
            }
        }
        if constexpr (ALIGN_EPI) { if (wr == 0) PG8_BAR; }
        if constexpr (!Epi::AFTER_DRAIN) { E(acc, cur, wr, wc, fr, fq); S.done(cur); }
        if (!has_next) break;
#pragma unroll
        for (int a = 0; a < 2; ++a)
#pragma unroll
            for (int b = 0; b < 2; ++b)
#pragma unroll
                for (int m = 0; m < 4; ++m)
#pragma unroll
                    for (int n = 0; n < 2; ++n) acc[a][b][m][n] = (f32x4){0.f, 0.f, 0.f, 0.f};
        cur = nxt; cA = nA; cB = nB; ++ui;
        if constexpr (ALIGN_EPI) { if (wr == 1) PG8_BAR; }
    }
    PG8_WAIT_V(0);
    if constexpr (!ALIGN_EPI) { if (wr == 0) PG8_BAR; }
    PG8_BAR;
    if constexpr (Epi::AFTER_DRAIN) { E.fused(acc, cur, wr, wc, fr, fq, lds, wid, lane); S.done(cur); }
#undef PG8_SA
#undef PG8_SB
#undef PG8_STAGE
#undef PG8_LDA
#undef PG8_LDB
#undef PG8_MMA
#undef PG8_WAIT_V
#undef PG8_WAIT_L
#undef PG8_BAR
#undef PG8_SCHED
}
}
namespace att {
#define ATT_LAS __attribute__((address_space(3)))
typedef unsigned short bf16_t;
typedef short bf16x8 __attribute__((ext_vector_type(8)));
typedef short s16x4 __attribute__((ext_vector_type(4)));
typedef short v4i16_t __attribute__((ext_vector_type(4)));
typedef float f32x16 __attribute__((ext_vector_type(16)));
typedef float f32x4 __attribute__((ext_vector_type(4)));
typedef unsigned u32x4 __attribute__((ext_vector_type(4)));
typedef float f32x2_t __attribute__((ext_vector_type(2)));
typedef __bf16 bf16x2_t __attribute__((ext_vector_type(2)));
constexpr float NEGF = -1e30f, LOG2E = 1.4426950408889634f;
constexpr int TILE_B = 16384;
constexpr int WSF_OFF = 131072;

__device__ __forceinline__ int crow(int r, int hi) { return (r & 3) + 8 * (r >> 2) + 4 * hi; }
__device__ __forceinline__ unsigned cvtpk(float lo, float hi) { f32x2_t v = {lo, hi}; bf16x2_t b = __builtin_convertvector(v, bf16x2_t); return __builtin_bit_cast(unsigned, b); }
__device__ __forceinline__ s16x4 vtr(const ATT_LAS char* p) { return __builtin_bit_cast(s16x4, __builtin_amdgcn_ds_read_tr16_b64_v4i16((ATT_LAS v4i16_t*)p)); }
__device__ __forceinline__ float bf2f(unsigned short b) { return __builtin_bit_cast(float, (unsigned)b << 16); }

__device__ __forceinline__ void stage_write(ATT_LAS char* tile, int idx, u32x4 kv, u32x4 vv) {
    const int key = idx >> 3, ch = idx & 7;
    *(ATT_LAS u32x4*)(tile + ch * 1024 + key * 16) = kv;
    *(ATT_LAS u32x4*)(tile + 8192 + (ch >> 2) * 4096 + (key >> 4) * 1024 + (key & 15) * 64 + (ch & 3) * 16) = vv;
}

struct WS { f32x16 o0, o1; float m, l; };

__device__ __forceinline__ void tile_step(WS& s, const ATT_LAS char* tile, const bf16x8 (&qr)[4], float fd0, float slope2, float Wf, ATT_LAS float* wsf, int lane) {
    const int r32 = lane & 31, hi = lane >> 5;
    const ATT_LAS char* kb = tile + hi * 1024 + r32 * 16;
    f32x16 p0, p1;
#pragma unroll
    for (int r = 0; r < 16; ++r) { p0[r] = 0.f; p1[r] = 0.f; }
#pragma unroll
    for (int d0 = 0; d0 < 4; ++d0) {
        const bf16x8 b0 = *(const ATT_LAS bf16x8*)(kb + d0 * 2048), b1 = *(const ATT_LAS bf16x8*)(kb + d0 * 2048 + 512);
        p0 = __builtin_amdgcn_mfma_f32_32x32x16_bf16(b0, qr[d0], p0, 0, 0, 0);
        p1 = __builtin_amdgcn_mfma_f32_32x32x16_bf16(b1, qr[d0], p1, 0, 0, 0);
    }
    float mx = NEGF;
#pragma unroll
    for (int r = 0; r < 16; ++r) {
        const float c = (float)((r & 3) + 8 * (r >> 2));
        const float a0 = __builtin_fabsf(fd0 + c), a1 = __builtin_fabsf(fd0 + (c + 32.f));
        const float x0 = __builtin_fmaf(-slope2, a0, p0[r]), x1 = __builtin_fmaf(-slope2, a1, p1[r]);
        p0[r] = (a0 <= Wf) ? x0 : NEGF; p1[r] = (a1 <= Wf) ? x1 : NEGF;
        mx = __builtin_fmaxf(mx, __builtin_fmaxf(p0[r], p1[r]));
    }
    mx = __builtin_fmaxf(mx, __shfl_xor(mx, 32));
    const float mn = __builtin_fmaxf(s.m, mx);
    const float f = __builtin_amdgcn_exp2f(s.m - mn);
    s.m = mn;
    float ls = 0.f;
#pragma unroll
    for (int r = 0; r < 16; ++r) { p0[r] = __builtin_amdgcn_exp2f(p0[r] - mn); p1[r] = __builtin_amdgcn_exp2f(p1[r] - mn); ls += p0[r] + p1[r]; }
    s.l = s.l * f + ls;
    if (__any(f != 1.0f)) {
        if (hi == 0) wsf[r32] = f;
#pragma unroll
        for (int i = 0; i < 4; ++i) { const f32x4 fv = *(const ATT_LAS f32x4*)(wsf + 8 * i + 4 * hi);
#pragma unroll
            for (int j = 0; j < 4; ++j) { s.o0[4 * i + j] *= fv[j]; s.o1[4 * i + j] *= fv[j]; } }
    }
    u32x4 pw[4];
#pragma unroll
    for (int j = 0; j < 4; ++j) { pw[0][j] = cvtpk(p0[2 * j], p0[2 * j + 1]); pw[1][j] = cvtpk(p0[8 + 2 * j], p0[9 + 2 * j]); pw[2][j] = cvtpk(p1[2 * j], p1[2 * j + 1]); pw[3][j] = cvtpk(p1[8 + 2 * j], p1[9 + 2 * j]); }
    const ATT_LAS char* vb = tile + 8192 + ((lane >> 4) & 1) * 32 + (lane & 3) * 8 + (4 * hi + ((lane & 15) >> 2)) * 64;
#pragma unroll
    for (int ks = 0; ks < 4; ++ks) {
        const s16x4 l0 = vtr(vb + ks * 1024), h0 = vtr(vb + ks * 1024 + 512), l1 = vtr(vb + 4096 + ks * 1024), h1 = vtr(vb + 4096 + ks * 1024 + 512);
        const bf16x8 v0 = (bf16x8){l0[0], l0[1], l0[2], l0[3], h0[0], h0[1], h0[2], h0[3]}, v1 = (bf16x8){l1[0], l1[1], l1[2], l1[3], h1[0], h1[1], h1[2], h1[3]};
        const bf16x8 pa = __builtin_bit_cast(bf16x8, pw[ks]);
        s.o0 = __builtin_amdgcn_mfma_f32_32x32x16_bf16(pa, v0, s.o0, 0, 0, 0);
        s.o1 = __builtin_amdgcn_mfma_f32_32x32x16_bf16(pa, v1, s.o1, 0, 0, 0);
    }
}

__device__ __forceinline__ void store_o(const WS& s, float inv, bf16_t* orow0, size_t rstride, ATT_LAS float* wsf, int lane) {
    const int r32 = lane & 31, hi = lane >> 5;
    if (hi == 0) wsf[r32] = inv;
#pragma unroll
    for (int i = 0; i < 4; ++i) { const f32x4 fv = *(const ATT_LAS f32x4*)(wsf + 8 * i + 4 * hi);
#pragma unroll
        for (int j = 0; j < 4; ++j) { const int r = 4 * i + j; bf16_t* p = orow0 + (size_t)crow(r, hi) * rstride + r32;
            p[0] = (bf16_t)(cvtpk(s.o0[r] * fv[j], 0.f) & 0xffffu); p[32] = (bf16_t)(cvtpk(s.o1[r] * fv[j], 0.f) & 0xffffu); } }
}

__device__ __forceinline__ void attn_a_item(int item, const bf16_t* qkv  , bf16_t* O  , const float* sink, ATT_LAS char* lds, const int tid) {
    const int lane = tid & 63, wave = __builtin_amdgcn_readfirstlane(tid >> 6), r32 = lane & 31, hi = lane >> 5;
    const int qb = item & 31, kvh = (item >> 5) & 3, b = item >> 7;
    const int q0 = qb * 64, tok0 = b * 2048;
    ATT_LAS float* wsf = (ATT_LAS float*)(lds + WSF_OFF) + wave * 64;
    {
        u32x4 kr[5], vr[5];
#pragma unroll
        for (int j = 0; j < 5; ++j) { const int ks = q0 - 128 + 64 * j;
            if (ks >= 0 && ks < 2048) { const bf16_t* src = qkv + (size_t)(tok0 + ks + (tid >> 3)) * 1536 + 1024 + kvh * 64 + (tid & 7) * 8; kr[j] = *(const u32x4*)src; vr[j] = *(const u32x4*)(src + 256); } }
#pragma unroll
        for (int j = 0; j < 5; ++j) { const int ks = q0 - 128 + 64 * j; if (ks >= 0 && ks < 2048) stage_write(lds + j * TILE_B, tid, kr[j], vr[j]); }
    }
    const int g = wave & 3, half = wave >> 2, hq = kvh * 4 + g, qpos = q0 + 32 * half + r32;
    bf16x8 qr[4];
#pragma unroll
    for (int d0 = 0; d0 < 4; ++d0) qr[d0] = *(const bf16x8*)(qkv + (size_t)(tok0 + qpos) * 1536 + hq * 64 + d0 * 16 + hi * 8);
    const float slope2 = __builtin_amdgcn_exp2f(-0.5f * (float)(hq + 1)) * LOG2E;
    __syncthreads();
    WS s;
#pragma unroll
    for (int r = 0; r < 16; ++r) { s.o0[r] = 0.f; s.o1[r] = 0.f; }
    s.m = NEGF; s.l = 0.f;
    for (int j = 0; j < 5; ++j) { const int ks = q0 - 128 + 64 * j;
        if (ks >= 0 && ks < 2048) tile_step(s, lds + j * TILE_B, qr, (float)(ks - qpos + 4 * hi), slope2, 128.f, wsf, lane); }
    const float lt = s.l + __shfl_xor(s.l, 32);
    const float inv = 1.0f / (lt + __builtin_amdgcn_exp2f(sink[hq] * LOG2E - s.m));
    store_o(s, inv, O + (size_t)(tok0 + q0 + 32 * half) * 1024 + hq * 64, 1024, wsf, lane);
    __syncthreads();
}

__device__ __forceinline__ void attn_b_item(int item, int gi, int dil, const bf16_t* qkv  , bf16_t* O  , float* lse  , ATT_LAS char* lds, const int tid) {
    const int lane = tid & 63, wave = __builtin_amdgcn_readfirstlane(tid >> 6), r32 = lane & 31, hi = lane >> 5;
    const int hp = item & 7, within = (item >> 3) & 15, b = item >> 7;
    const int res = within % dil, qb = within / dil, L = 2048 / dil, u0 = qb * 128, tokb = b * 2048 + res;
    ATT_LAS float* wsf = (ATT_LAS float*)(lds + WSF_OFF) + wave * 64;
    {
        u32x4 kr[8], vr[8];
#pragma unroll
        for (int t = 0; t < 8; ++t) { const int j = t & 3, hh = t >> 2, ks = u0 - 64 + 64 * j;
            if (ks >= 0 && ks < L) { const bf16_t* src = qkv + (size_t)(tokb + (ks + (tid >> 3)) * dil) * 3072 + 1024 + (2 * hp + hh) * 64 + (tid & 7) * 8; kr[t] = *(const u32x4*)src; vr[t] = *(const u32x4*)(src + 1024); } }
#pragma unroll
        for (int t = 0; t < 8; ++t) { const int j = t & 3, ks = u0 - 64 + 64 * j; if (ks >= 0 && ks < L) stage_write(lds + t * TILE_B, tid, kr[t], vr[t]); }
    }
    const int hh = wave >> 2, wq = wave & 3, h = 2 * hp + hh, qpos = u0 + 32 * wq + r32;
    const size_t qtok = (size_t)(tokb + qpos * dil);
    bf16x8 qr[4];
#pragma unroll
    for (int d0 = 0; d0 < 4; ++d0) qr[d0] = *(const bf16x8*)(qkv + qtok * 3072 + h * 64 + d0 * 16 + hi * 8);
    const float slope2 = __builtin_amdgcn_exp2f(-0.5f * (float)(h + 1)) * LOG2E * (float)dil;
    bf16_t* orow0 = O + (size_t)(tokb + (u0 + 32 * wq) * dil) * 1024 + h * 64;
    const size_t rstride = (size_t)dil * 1024;
    WS s;
    if (gi == 0) {
#pragma unroll
        for (int r = 0; r < 16; ++r) { s.o0[r] = 0.f; s.o1[r] = 0.f; }
        s.m = NEGF; s.l = 0.f;
    } else {
        s.m = lse[qtok * 16 + h]; s.l = (hi == 0) ? 1.0f : 0.0f;
#pragma unroll
        for (int r = 0; r < 16; ++r) { const bf16_t* p = orow0 + (size_t)crow(r, hi) * rstride + r32; s.o0[r] = bf2f(p[0]); s.o1[r] = bf2f(p[32]); }
    }
    __syncthreads();
    for (int jj = 0; jj < 3; ++jj) { const int j = (wq >> 1) + jj, ks = u0 - 64 + 64 * j;
        if (ks >= 0 && ks < L) tile_step(s, lds + (hh * 4 + j) * TILE_B, qr, (float)(ks - qpos + 4 * hi), slope2, 64.f, wsf, lane); }
    const float lt = s.l + __shfl_xor(s.l, 32);
    if (hi == 0) lse[qtok * 16 + h] = s.m + __builtin_log2f(lt);
    store_o(s, 1.0f / lt, orow0, rstride, wsf, lane);
    __syncthreads();
}
}

#ifndef MK_MULTI
#define MK_MULTI 0
#endif
#define LAS __attribute__((address_space(3)))
typedef unsigned short bf16;
typedef unsigned v4u __attribute__((ext_vector_type(4)));
typedef float f32x4 __attribute__((ext_vector_type(4)));
constexpr int NWAVES = 8, T = 16 * 2048, D = 1024, FF = 2816, NPH = 16;
constexpr size_t MiB = 1u << 20;
constexpr size_t WS_SSQ = 0, WS_LSE = 2 * MiB;
constexpr size_t WS_WQKVA = 4 * MiB, WS_WOA = 7 * MiB, WS_WGU0 = 9 * MiB, WS_WD0 = 20 * MiB, WS_WQKVB = 26 * MiB, WS_WOB = 44 * MiB, WS_WGU1 = 46 * MiB, WS_WD1 = 57 * MiB;
constexpr size_t WS_CTL = 63 * MiB, CTL_BYTES = 16384;
constexpr int MISC_OFF = 133120;
constexpr size_t WS_XB = 64 * MiB, WS_O = 128 * MiB, WS_BIG = 192 * MiB, WS_END = 384 * MiB;
constexpr int LDS_BYTES = 147456;

__device__ __forceinline__ unsigned f2bf(float f) { unsigned u = __builtin_bit_cast(unsigned, f); return (u + 0x7fffu + ((u >> 16) & 1u)) >> 16; }
__device__ __forceinline__ unsigned pk2(float lo, float hi) { return f2bf(lo) | (f2bf(hi) << 16); }
__device__ __forceinline__ float wave_sum(float v) {
#pragma unroll
    for (int o = 1; o < 64; o <<= 1) v += __shfl_xor(v, o);
    return v;
}
#define XB_TMO      128
#define XB_XCNT(j)  (256  + 64 * (j))
#define XB_XSUB(j)  (1280 + 64 * (j))
#define XB_XGEN(j)  (2304 + 64 * (j))
#define XB_TOP      3328
#define XB_TOPGEN   3392
#define XCD_BAR_WORDS 3456
#define XB_SPIN_CAP (1u << 18)

__device__ __forceinline__ unsigned xb_ld(unsigned* p)              { return __hip_atomic_load(p, __ATOMIC_RELAXED, __HIP_MEMORY_SCOPE_AGENT); }
__device__ __forceinline__ unsigned xb_add(unsigned* p, unsigned v) { return __hip_atomic_fetch_add(p, v, __ATOMIC_RELAXED, __HIP_MEMORY_SCOPE_AGENT); }
__device__ __forceinline__ unsigned xb_xcc_id() { return (unsigned)__builtin_amdgcn_s_getreg((3 << 11) | 20) & 0xFu; }
#define XB_SPIN(cond, bar) do { unsigned _sp = 0; while (cond) { __builtin_amdgcn_s_sleep(1); \
    if ((++_sp & 255u) == 0u) { if (xb_ld(&(bar)[XB_TMO])) break; if (_sp > XB_SPIN_CAP) { atomicAdd(&(bar)[XB_TMO], 1u); break; } } } } while (0)

struct XcdBarrier {
    unsigned* bar; unsigned x;
    volatile LAS unsigned* st;
};

__device__ __forceinline__ XcdBarrier xcd_barrier_post(unsigned* bar, volatile LAS unsigned* st) {
    XcdBarrier b; b.bar = bar; b.x = xb_xcc_id(); b.st = st;
    if (threadIdx.x == 0) (void)xb_add(&bar[XB_XCNT(b.x)], 1u);
    return b;
}
__device__ __forceinline__ void xcd_barrier_complete(unsigned* bar, unsigned x, unsigned& nloc, unsigned& nx) {
    const unsigned G = gridDim.x * gridDim.y * gridDim.z;
    unsigned sum, cnt, mine, sp = 0u;
    for (;;) {
        sum = 0u; cnt = 0u; mine = 0u;
#pragma unroll
        for (unsigned j = 0; j < 16; ++j) { const unsigned c = xb_ld(&bar[XB_XCNT(j)]); sum += c; cnt += (c > 0u) ? 1u : 0u; mine = (j == x) ? c : mine; }
        if (sum == G) break;
        __builtin_amdgcn_s_sleep(1);
        if ((++sp & 255u) == 0u) { if (xb_ld(&bar[XB_TMO])) break; if (sp > XB_SPIN_CAP) { atomicAdd(&bar[XB_TMO], 1u); break; } }
    }
    nloc = mine > 0u ? mine : 1u; nx = cnt > 0u ? cnt : 1u;
}

__device__ __forceinline__ void xcd_barrier(const XcdBarrier& b) {
    asm volatile("s_waitcnt vmcnt(0)" ::: "memory");
    __syncthreads();
    if (threadIdx.x == 0) {
        unsigned* bar = b.bar;
        __builtin_amdgcn_s_waitcnt(0);
        unsigned nloc = b.st[0], nx = b.st[1];
        if (nloc == 0u) { xcd_barrier_complete(bar, b.x, nloc, nx); b.st[0] = nloc; b.st[1] = nx; }
        const unsigned old = xb_add(&bar[XB_XSUB(b.x)], 1u);
        const unsigned gen = old / nloc;
        if (old + 1u == (gen + 1u) * nloc) {
            __builtin_amdgcn_fence(__ATOMIC_RELEASE, "agent");
            asm volatile("s_waitcnt vmcnt(0)" ::: "memory");
            const unsigned og = xb_add(&bar[XB_TOP], 1u);
            const unsigned tg = og / nx;
            if (og + 1u == (tg + 1u) * nx) xb_add(&bar[XB_TOPGEN], 1u);
            else XB_SPIN(xb_ld(&bar[XB_TOPGEN]) == tg, bar);
            __builtin_amdgcn_fence(__ATOMIC_ACQUIRE, "agent");
            xb_add(&bar[XB_XGEN(b.x)], 1u);
            asm volatile("s_waitcnt vmcnt(0)" ::: "memory");
        } else {
            XB_SPIN(xb_ld(&bar[XB_XGEN(b.x)]) == gen, bar);
            __builtin_amdgcn_fence(__ATOMIC_ACQUIRE, "agent");
            asm volatile("s_waitcnt vmcnt(0)" ::: "memory");
        }
    }
    __syncthreads();
}

__device__ __forceinline__ void transpose_item(const float* W, int K, int N, bf16* WT, const float* gs, int mode, LAS float* scr, int item, int lane) {
    const int nblk = N / 32, kb = item / nblk, nb = item % nblk, k0 = 64 * kb, n0 = 32 * nb;
#pragma unroll 8
    for (int i = 0; i < 32; ++i) { const int kk = 2 * i + (lane >> 5); const float sc = gs ? gs[k0 + kk] : 1.0f; scr[kk * 33 + (lane & 31)] = W[(size_t)(k0 + kk) * N + n0 + (lane & 31)] * sc; }
    asm volatile("s_waitcnt lgkmcnt(0)" ::: "memory");
    const int c = lane & 7;
    const int rbase = (mode == 0) ? n0 : (256 * (n0 >> 7) + (n0 & 127) + (mode == 2 ? 128 : 0));
#pragma unroll
    for (int j = 0; j < 4; ++j) { const int n = (lane >> 3) + 8 * j; const LAS float* s = scr + (8 * c) * 33 + n;
        v4u o; o.x = pk2(s[0 * 33], s[1 * 33]); o.y = pk2(s[2 * 33], s[3 * 33]); o.z = pk2(s[4 * 33], s[5 * 33]); o.w = pk2(s[6 * 33], s[7 * 33]);
        *(v4u*)(WT + (size_t)(rbase + n) * K + k0 + 8 * c) = o; }
    asm volatile("s_waitcnt lgkmcnt(0)" ::: "memory");
}

struct Args { const float* in[12]; float* out; unsigned char* ws; int ph_lo, ph_hi; };

__global__ void __launch_bounds__(NWAVES * 64, 2) fwd_megakernel(Args a) {
    extern __shared__ __attribute__((aligned(16))) unsigned char lds_raw[];
    LAS unsigned char* lds = (LAS unsigned char*)lds_raw;
    cg::grid_group grid = cg::this_grid();
    const int G = gridDim.x, bid = blockIdx.x;
    unsigned char* ws = a.ws;
    float* ssqp = (float*)(ws + WS_SSQ); float* lse = (float*)(ws + WS_LSE);
    bf16* XB = (bf16*)(ws + WS_XB); bf16* OB = (bf16*)(ws + WS_O); bf16* BIG = (bf16*)(ws + WS_BIG);
    const int NGW = G * NWAVES;
    if (threadIdx.x < 2) ((volatile LAS unsigned*)(lds + MISC_OFF))[threadIdx.x] = 0u;
    __syncthreads();
    XcdBarrier bar = xcd_barrier_post((unsigned*)(ws + WS_CTL), (volatile LAS unsigned*)(lds + MISC_OFF));

    for (int ph = a.ph_lo; ph < a.ph_hi; ++ph) {
        int tid = threadIdx.x; asm volatile("" : "+v"(tid));
        const int lane = tid & 63, wave = __builtin_amdgcn_readfirstlane(tid >> 6), gw = bid * NWAVES + wave;
        if (ph == 0) {
            LAS float* scr = (LAS float*)(lds + wave * 16384);
            constexpr int I_QA = 16 * 48, I_O = 16 * 32, I_G = 16 * 88, I_D = 44 * 32, I_QB = 16 * 288;
            constexpr int NITEMS = I_QA + 2 * I_O + 4 * I_G + 2 * I_D + I_QB;
            for (int it = gw; it < NITEMS; it += NGW) {
                int r = it;
                if (r < I_QA) { transpose_item(a.in[3], D, 1536, (bf16*)(ws + WS_WQKVA), a.in[1], 0, scr, r, lane); continue; } r -= I_QA;
                if (r < I_O) { transpose_item(a.in[4], D, D, (bf16*)(ws + WS_WOA), nullptr, 0, scr, r, lane); continue; } r -= I_O;
                if (r < I_O) { transpose_item(a.in[7], D, D, (bf16*)(ws + WS_WOB), nullptr, 0, scr, r, lane); continue; } r -= I_O;
                if (r < I_G) { transpose_item(a.in[8], D, FF, (bf16*)(ws + WS_WGU0), a.in[2], 1, scr, r, lane); continue; } r -= I_G;
                if (r < I_G) { transpose_item(a.in[9], D, FF, (bf16*)(ws + WS_WGU0), a.in[2], 2, scr, r, lane); continue; } r -= I_G;
                if (r < I_G) { transpose_item(a.in[8] + (size_t)D * FF, D, FF, (bf16*)(ws + WS_WGU1), a.in[2] + D, 1, scr, r, lane); continue; } r -= I_G;
                if (r < I_G) { transpose_item(a.in[9] + (size_t)D * FF, D, FF, (bf16*)(ws + WS_WGU1), a.in[2] + D, 2, scr, r, lane); continue; } r -= I_G;
                if (r < I_D) { transpose_item(a.in[10], FF, D, (bf16*)(ws + WS_WD0), nullptr, 0, scr, r, lane); continue; } r -= I_D;
                if (r < I_D) { transpose_item(a.in[10] + (size_t)FF * D, FF, D, (bf16*)(ws + WS_WD1), nullptr, 0, scr, r, lane); continue; } r -= I_D;
                transpose_item(a.in[6], D, 9216, (bf16*)(ws + WS_WQKVB), a.in[1] + D, 0, scr, r, lane);
            }
            for (int m = gw; m < T; m += NGW) {
                const f32x4* xr = (const f32x4*)(a.in[0] + (size_t)m * D) + lane;
                f32x4 v[4]; float s = 0.f;
#pragma unroll
                for (int j = 0; j < 4; ++j) { v[j] = xr[64 * j]; s += (v[j].x * v[j].x + v[j].y * v[j].y) + (v[j].z * v[j].z + v[j].w * v[j].w); }
                s = wave_sum(s);
                unsigned long long* o8 = (unsigned long long*)(XB + (size_t)m * D) + lane;
#pragma unroll
                for (int j = 0; j < 4; ++j) o8[64 * j] = (unsigned long long)pk2(v[j].x, v[j].y) | ((unsigned long long)pk2(v[j].z, v[j].w) << 32);
                if (lane < 16) ssqp[(size_t)m * 16 + lane] = (lane == 0) ? s : 0.f;
            }
            __syncthreads();
        } else if (ph == 1 || ph == 6 || ph == 8 || ph == 10) {
            const int gi = (ph - 6) >> 1;
            const int N = (ph == 1) ? 1536 : 3072;
            const bf16* Bt = (ph == 1) ? (const bf16*)(ws + WS_WQKVA) : (const bf16*)(ws + WS_WQKVB) + (size_t)gi * 3072 * D;
            pg8::Gemm g{XB, Bt, T, N, D}; pg8::StaticOrder S; S.init(T, N, G, bid);
            pg8::EpiQKV E{BIG, N, ssqp, 4};
#ifndef DIS_QKV
            pg8::gemm_phase<pg8::EpiQKV, pg8::StaticOrder, true, true>(lds, g, S, E, tid);
#endif
        } else if (ph == 2) {
#ifndef DIS_ATTA
            for (int it = bid; it < 2048; it += G) att::attn_a_item(it, BIG, OB, a.in[5], (LAS char*)lds, tid);
#endif
        } else if (ph == 7 || ph == 9 || ph == 11) {
            const int gi = (ph - 7) >> 1, dil = (gi == 0) ? 1 : (gi == 1 ? 4 : 16);
#ifndef DIS_ATTB
            for (int it = bid; it < 2048; it += G) att::attn_b_item(it, gi, dil, BIG, OB, lse, (LAS char*)lds, tid);
#endif
        } else if (ph == 3 || ph == 5 || ph == 12 || ph == 14) {
            const bool down = (ph == 5 || ph == 14);
            const bf16* A = down ? BIG : OB;
            const bf16* Bt = (const bf16*)(ws + (ph == 3 ? WS_WOA : ph == 5 ? WS_WD0 : ph == 12 ? WS_WOB : WS_WD1));
            pg8::Gemm g{A, Bt, T, D, down ? FF : D}; pg8::StaticOrder S; S.init(T, D, G, bid);
            pg8::EpiResid E{(ph == 3) ? a.in[0] : a.out, a.out, XB, ssqp};
#ifndef DIS_RES
            pg8::gemm_phase<pg8::EpiResid, pg8::StaticOrder, true, true>(lds, g, S, E, tid);
#endif
        } else if (ph == 4 || ph == 13) {
            const bf16* Bt = (const bf16*)(ws + (ph == 4 ? WS_WGU0 : WS_WGU1));
            pg8::Gemm g{XB, Bt, T, 2 * FF, D}; pg8::StaticOrder S; S.init(T, 2 * FF, G, bid);
            pg8::EpiSwiGLU E{BIG, ssqp};
#ifndef DIS_SWI
            pg8::gemm_phase<pg8::EpiSwiGLU, pg8::StaticOrder, true, true>(lds, g, S, E, tid);
#endif
        } else {
            const float* gf = a.in[11];
            for (int m = gw; m < T; m += NGW) {
                float s = (lane < 16) ? ssqp[(size_t)m * 16 + lane] : 0.f;
                s = wave_sum(s);
                const float r = rsqrtf(s * (1.0f / 1024.0f) + 1e-6f);
                f32x4* xr = (f32x4*)(a.out + (size_t)m * D) + lane;
#pragma unroll
                for (int j = 0; j < 4; ++j) { const f32x4 gv = ((const f32x4*)gf)[lane + 64 * j]; f32x4 v = xr[64 * j]; v = v * r * gv; xr[64 * j] = v; }
            }
        }
        if (ph + 1 < a.ph_hi) {
            if (ph == 0) { __threadfence(); grid.sync(); __builtin_amdgcn_fence(__ATOMIC_ACQUIRE, "agent"); }
            else xcd_barrier(bar);
        }
    }
}

extern "C" void kernel_launch(void* const* d_in, const int* in_sizes, int n_in, void* d_out, int out_size, void* d_ws, size_t ws_size, hipStream_t stream) {
    static int grid = 0;
    if (grid == 0) {
        int dev = 0, cus = 0, per_cu = 0;
        if (n_in != 12 || out_size != T * D || ws_size < WS_END) { fprintf(stderr, "kernel_launch: unexpected shapes (n_in %d out %d ws %zu)\n", n_in, out_size, ws_size); grid = -1; return; }
        hipGetDevice(&dev);
        hipDeviceGetAttribute(&cus, hipDeviceAttributeMultiprocessorCount, dev);
        if (hipFuncSetAttribute((const void*)fwd_megakernel, hipFuncAttributeMaxDynamicSharedMemorySize, LDS_BYTES) != hipSuccess) { fprintf(stderr, "kernel_launch: hipFuncSetAttribute failed\n"); grid = -1; return; }
        if (hipOccupancyMaxActiveBlocksPerMultiprocessor(&per_cu, (const void*)fwd_megakernel, NWAVES * 64, LDS_BYTES) != hipSuccess || per_cu < 1) { fprintf(stderr, "kernel_launch: occupancy query says %d\n", per_cu); per_cu = 1; }
        (void)hipGetLastError();
        grid = cus;
        fprintf(stderr, "kernel_launch: grid %d (per_cu %d)\n", grid, per_cu);
    }
    if (grid < 0) return;
    if (hipMemsetAsync((char*)d_ws + WS_CTL, 0, CTL_BYTES, stream) != hipSuccess) { fprintf(stderr, "kernel_launch: memset failed\n"); return; }
    Args a{};
    for (int i = 0; i < 12; ++i) a.in[i] = (const float*)d_in[i];
    a.out = (float*)d_out; a.ws = (unsigned char*)d_ws;
#if MK_MULTI
    for (int ph = 0; ph < NPH; ++ph) {
        a.ph_lo = ph; a.ph_hi = ph + 1;
        void* args[] = {&a};
        hipError_t e = hipLaunchCooperativeKernel((const void*)fwd_megakernel, dim3(grid), dim3(NWAVES * 64), args, LDS_BYTES, stream);
        if (e != hipSuccess) { fprintf(stderr, "launch %d failed: %s\n", ph, hipGetErrorString(e)); break; }
    }
#else
    a.ph_lo = 0; a.ph_hi = NPH;
    void* args[] = {&a};
    hipError_t e = hipLaunchCooperativeKernel((const void*)fwd_megakernel, dim3(grid), dim3(NWAVES * 64), args, LDS_BYTES, stream);
    if (e != hipSuccess) fprintf(stderr, "cooperative launch failed: %s (grid %d)\n", hipGetErrorString(e), grid);
#endif
}
```

```cpp
#include <hip/hip_runtime.h>
#include <hip/hip_cooperative_groups.h>
#include <cstdio>
#include <cstdint>
namespace cg = cooperative_groups;
namespace pg8 {
#define PG8_LAS __attribute__((address_space(3)))
typedef unsigned short bf16_t;
typedef short bf16x8 __attribute__((ext_vector_type(8)));
typedef float f32x4 __attribute__((ext_vector_type(4)));
typedef unsigned u32x4 __attribute__((ext_vector_type(4)));
constexpr int BM = 256, BK = 64, HALF = 128, HTB = HALF * BK * 2  , STAGE_BYTES = 8 * HTB, NXCD = 8, WGM = 8;

__host__ __device__ __forceinline__ int lds_byte(int r, int c) { const int st = (r >> 4) * 2 + (c >> 5), rr = r & 15, cc = c & 31, ob = rr * 64 + cc * 2; return st * 1024 + (ob ^ (((ob >> 9) & 1) << 5)); }
__host__ __device__ __forceinline__ void stage_rc(int b, int& R, int& C) { const int st = b / 1024, sb = b % 1024, swz = sb ^ (((sb >> 9) & 1) << 5); R = (st >> 1) * 16 + swz / 64; C = (st & 1) * 32 + (swz % 64) / 2; }
__host__ __device__ __forceinline__ int perm32(int rho) { const int n = rho >> 4, i = rho & 15; return 8 * (i >> 2) + 4 * n + (i & 3); }

struct Unit { int pm, pn; };
struct Gemm { const bf16_t* A; const bf16_t* Bt; int M, N, K; };

struct StaticOrder {
    int nM, nN, nwg, G, c;
    __host__ __device__ void init(int M, int N, int G_, int c_) { nM = M / BM; nN = N / BM; nwg = nM * nN; G = G_; c = c_; }
    __host__ __device__ bool next(int i, Unit& u) const {
        const long L = (long)i * G + c; if (L >= nwg) return false;
        int wgid = (int)L; { const int q = nwg / NXCD, r = nwg % NXCD, xcd = wgid % NXCD, off = wgid / NXCD; wgid = (xcd < r ? xcd * (q + 1) : r * (q + 1) + (xcd - r) * q) + off; }
        const int nig = WGM * nN, gid = wgid / nig, fm = gid * WGM, gsz = (nM - fm) < WGM ? (nM - fm) : WGM;
        u.pm = fm + ((wgid % nig) % gsz); u.pn = (wgid % nig) / gsz; return true;
    }
    __device__ __forceinline__ void a_ready(const Unit&) const {}
    __device__ __forceinline__ void done(const Unit&) const {}
};

__device__ __forceinline__ unsigned cvt_pk_bf16(float lo, float hi) { unsigned r; asm volatile("v_cvt_pk_bf16_f32 %0, %1, %2" : "=v"(r) : "v"(lo), "v"(hi)); return r; }
constexpr float RMS_EPS_F = 1e-6f;
constexpr float QK_C2 = 0.125f * 1.4426950408889634f;
__device__ __forceinline__ float row_rscale(const float* ssqp, int row, int fq) {
    const f32x4 p = *(const f32x4*)(ssqp + (size_t)row * 16 + 4 * fq);
    float s = (p[0] + p[1]) + (p[2] + p[3]);
    s += __shfl_xor(s, 16); s += __shfl_xor(s, 32);
    return rsqrtf(s * (1.0f / 1024.0f) + RMS_EPS_F);
}
struct EpiQKV {
    static constexpr bool PERM = true, AFTER_DRAIN = false;
    bf16_t* O; int ldc; const float* ssqp; int qtiles;
    __device__ __forceinline__ void operator()(const f32x4 (&acc)[2][2][4][2], const Unit& u, int wr, int wc, int fr, int fq) const {
        const int row0 = u.pm * BM + wr * 64 + fr, col0 = u.pn * BM + wc * 32 + 8 * fq;
        const float sc = (u.pn < qtiles) ? QK_C2 : 1.0f;
#pragma unroll
        for (int ai = 0; ai < 2; ++ai)
#pragma unroll
            for (int m = 0; m < 4; ++m) { const int row = row0 + ai * HALF + m * 16; const float r = row_rscale(ssqp, row, fq) * sc;
                bf16_t* rowp = O + (size_t)row * ldc + col0;
#pragma unroll
                for (int bj = 0; bj < 2; ++bj) { const f32x4 v0 = acc[ai][bj][m][0] * r, v1 = acc[ai][bj][m][1] * r;
                    u32x4 w; w.x = cvt_pk_bf16(v0[0], v0[1]); w.y = cvt_pk_bf16(v0[2], v0[3]); w.z = cvt_pk_bf16(v1[0], v1[1]); w.w = cvt_pk_bf16(v1[2], v1[3]);
                    *(u32x4*)(rowp + bj * HALF) = w; } }
    }
};
struct EpiResid {
    static constexpr bool PERM = true, AFTER_DRAIN = false;
    bf16_t* xb; float* ssqp_out;
    __device__ __forceinline__ void operator()(const f32x4 (&acc)[2][2][4][2], const Unit& u, int wr, int wc, int fr, int fq) const {
        const int row0 = u.pm * BM + wr * 64 + fr, col0 = u.pn * BM + wc * 32 + 8 * fq;
#pragma unroll
        for (int ai = 0; ai < 2; ++ai)
#pragma unroll
            for (int m = 0; m < 4; ++m) { const int row = row0 + ai * HALF + m * 16; const size_t off = (size_t)row * 1024 + col0; float ss = 0.f;
#pragma unroll
                for (int bj = 0; bj < 2; ++bj) {
                    const u32x4 b = *(const u32x4*)(xb + off + bj * HALF);
                    f32x4 v0 = acc[ai][bj][m][0], v1 = acc[ai][bj][m][1];
                    v0[0] += __builtin_bit_cast(float, b.x << 16); v0[1] += __builtin_bit_cast(float, b.x & 0xffff0000u); v0[2] += __builtin_bit_cast(float, b.y << 16); v0[3] += __builtin_bit_cast(float, b.y & 0xffff0000u);
                    v1[0] += __builtin_bit_cast(float, b.z << 16); v1[1] += __builtin_bit_cast(float, b.z & 0xffff0000u); v1[2] += __builtin_bit_cast(float, b.w << 16); v1[3] += __builtin_bit_cast(float, b.w & 0xffff0000u);
                    u32x4 w; w.x = cvt_pk_bf16(v0[0], v0[1]); w.y = cvt_pk_bf16(v0[2], v0[3]); w.z = cvt_pk_bf16(v1[0], v1[1]); w.w = cvt_pk_bf16(v1[2], v1[3]);
                    *(u32x4*)(xb + off + bj * HALF) = w;
                    ss += (v0[0] * v0[0] + v0[1] * v0[1]) + (v0[2] * v0[2] + v0[3] * v0[3]) + (v1[0] * v1[0] + v1[1] * v1[1]) + (v1[2] * v1[2] + v1[3] * v1[3]); }
                ss += __shfl_xor(ss, 16); ss += __shfl_xor(ss, 32);
                if (fq == 0) ssqp_out[(size_t)row * 16 + u.pn * 4 + wc] = ss; }
    }
};
struct EpiSwiGLU {
    static constexpr bool PERM = true, AFTER_DRAIN = false;
    bf16_t* H; const float* ssqp;
    __device__ __forceinline__ void operator()(const f32x4 (&acc)[2][2][4][2], const Unit& u, int wr, int wc, int fr, int fq) const {
        const int row0 = u.pm * BM + wr * 64 + fr, hcol = u.pn * HALF + wc * 32 + 8 * fq;
#pragma unroll
        for (int ai = 0; ai < 2; ++ai)
#pragma unroll
            for (int m = 0; m < 4; ++m) { const int row = row0 + ai * HALF + m * 16; const float r = row_rscale(ssqp, row, fq);
                float hv[8];
#pragma unroll
                for (int n = 0; n < 2; ++n)
#pragma unroll
                    for (int j = 0; j < 4; ++j) { const float g = acc[ai][0][m][n][j] * r, up = acc[ai][1][m][n][j] * r;
                        const float sg = g * __builtin_amdgcn_rcpf(1.0f + __builtin_amdgcn_exp2f(-1.4426950408889634f * g)); hv[n * 4 + j] = sg * up; }
                u32x4 w; w.x = cvt_pk_bf16(hv[0], hv[1]); w.y = cvt_pk_bf16(hv[2], hv[3]); w.z = cvt_pk_bf16(hv[4], hv[5]); w.w = cvt_pk_bf16(hv[6], hv[7]);
                *(u32x4*)(H + (size_t)row * 2816 + hcol) = w; }
    }
};

template <class Epi, class Sched, bool ALIGN_EPI = false, bool SP2 = false>
__device__ __forceinline__ void gemm_phase(PG8_LAS unsigned char* lds, const Gemm g, const Sched& S, const Epi& E, const int tid) {
    const int wid = __builtin_amdgcn_readfirstlane(tid >> 6), lane = tid & 63, wr = wid >> 2, wc = wid & 3, fr = lane & 15, fq = lane >> 4;
    const int K = g.K, nt = K / BK;
    unsigned voffA[2], voffB[2];
#pragma unroll
    for (int i = 0; i < 2; ++i) { int R, C; stage_rc(tid * 16 + i * 8192, R, C); const int Rb = Epi::PERM ? ((R & ~31) + perm32(R & 31)) : R;
        voffA[i] = (unsigned)(R * K + C) * 2u; voffB[i] = (unsigned)(Rb * K + C) * 2u; }
    const size_t kstep = (size_t)(BK * 2);
    const size_t hstep = (size_t)HALF * K * 2;
    const size_t tstep = 2 * hstep;
    const unsigned ldsw = (unsigned)wid * 1024u;
    const int aoff = lds_byte(wr * 64 + fr, fq * 8), boff = lds_byte(wc * 32 + fr, fq * 8);
#define PG8_SA(b, h) (((b) * 2 + (h)) * HTB)
#define PG8_SB(b, h) ((4 + (b) * 2 + (h)) * HTB)
#define PG8_STAGE(bufoff, gbase, voff) do { _Pragma("unroll") for (int _i = 0; _i < 2; ++_i) \
        __builtin_amdgcn_global_load_lds((const unsigned*)((const char*)(gbase) + (voff)[_i]), (PG8_LAS unsigned*)(lds + (bufoff) + ldsw + _i * 8192), 16, 0, 0); } while (0)
#define PG8_LDA(dst, b, h) do { _Pragma("unroll") for (int m = 0; m < 4; ++m) _Pragma("unroll") for (int k = 0; k < 2; ++k) dst[m][k] = *(const PG8_LAS bf16x8*)(lds + PG8_SA(b, h) + aoff + m * 2048 + k * 1024); } while (0)
#define PG8_LDB(dst, b, h) do { _Pragma("unroll") for (int n = 0; n < 2; ++n) _Pragma("unroll") for (int k = 0; k < 2; ++k) dst[n][k] = *(const PG8_LAS bf16x8*)(lds + PG8_SB(b, h) + boff + n * 2048 + k * 1024); } while (0)
#define PG8_MMA(ai, bj, At, Bt) do { __builtin_amdgcn_s_setprio(1); _Pragma("unroll") for (int m = 0; m < 4; ++m) _Pragma("unroll") for (int n = 0; n < 2; ++n) _Pragma("unroll") for (int k = 0; k < 2; ++k) \
        acc[ai][bj][m][n] = __builtin_amdgcn_mfma_f32_16x16x32_bf16(Bt[n][k], At[m][k], acc[ai][bj][m][n], 0, 0, 0); __builtin_amdgcn_s_setprio(0); } while (0)
#define PG8_WAIT_V(n) asm volatile("s_waitcnt vmcnt(" #n ")" ::: "memory")
#define PG8_WAIT_L(n) asm volatile("s_waitcnt lgkmcnt(" #n ")" ::: "memory")
#define PG8_BAR __builtin_amdgcn_s_barrier()
#define PG8_SCHED __builtin_amdgcn_sched_barrier(0)
    Unit cur, nxt; int ui = 0;
    if (!S.next(0, cur)) return;
    f32x4 acc[2][2][4][2];
#pragma unroll
    for (int a = 0; a < 2; ++a)
#pragma unroll
        for (int b = 0; b < 2; ++b)
#pragma unroll
            for (int m = 0; m < 4; ++m)
#pragma unroll
                for (int n = 0; n < 2; ++n) acc[a][b][m][n] = (f32x4){0.f, 0.f, 0.f, 0.f};
    bf16x8 At[4][2], B0[2][2], B1[2][2];
    const char* cA = (const char*)g.A + (size_t)cur.pm * tstep; const char* cB = (const char*)g.Bt + (size_t)cur.pn * tstep;
    S.a_ready(cur);
    if constexpr (SP2) {
        PG8_STAGE(PG8_SB(0, 0), cB, voffB); PG8_STAGE(PG8_SB(0, 1), cB + hstep, voffB); PG8_STAGE(PG8_SA(0, 0), cA, voffA); PG8_STAGE(PG8_SA(0, 1), cA + hstep, voffA);
        if (wr == 1) PG8_BAR;
        PG8_WAIT_V(2); PG8_BAR;
        PG8_STAGE(PG8_SB(1, 0), cB + kstep, voffB); PG8_STAGE(PG8_SA(1, 0), cA + kstep, voffA); PG8_STAGE(PG8_SB(1, 1), cB + hstep + kstep, voffB);
        PG8_WAIT_V(6); PG8_BAR;
    } else {
        PG8_STAGE(PG8_SB(0, 0), cB, voffB); PG8_STAGE(PG8_SA(0, 0), cA, voffA); PG8_STAGE(PG8_SB(0, 1), cB + hstep, voffB); PG8_STAGE(PG8_SA(0, 1), cA + hstep, voffA);
        if (wr == 1) PG8_BAR;
        PG8_WAIT_V(4); PG8_BAR;
        PG8_STAGE(PG8_SB(1, 0), cB + kstep, voffB); PG8_STAGE(PG8_SA(1, 0), cA + kstep, voffA); PG8_STAGE(PG8_SB(1, 1), cB + hstep + kstep, voffB);
        PG8_WAIT_V(6); PG8_BAR;
    }
    for (;;) {
        const bool has_next = S.next(ui + 1, nxt);
        const char* nA = has_next ? (const char*)g.A + (size_t)nxt.pm * tstep : cA; const char* nB = has_next ? (const char*)g.Bt + (size_t)nxt.pn * tstep : cB;
        for (int t = 0; t < nt; t += 2) {
            const bool last = (t == nt - 2);
            const char* a1 = cA + (size_t)(t + 1) * kstep;
            const char* a2 = last ? nA : cA + (size_t)(t + 2) * kstep; const char* b2 = last ? nB : cB + (size_t)(t + 2) * kstep;
            const char* a3 = a2 + kstep; const char* b3 = b2 + kstep;
            if (last && has_next) S.a_ready(nxt);
            if constexpr (SP2) {
            PG8_LDB(B0, 0, 0); PG8_LDB(B1, 0, 1); PG8_SCHED; PG8_LDA(At, 0, 0); PG8_STAGE(PG8_SA(1, 1), a1 + hstep, voffA);
            PG8_WAIT_V(8); PG8_WAIT_L(0); PG8_BAR; PG8_MMA(0, 0, At, B0); PG8_MMA(0, 1, At, B1); PG8_BAR; PG8_SCHED;
            PG8_LDA(At, 0, 1); PG8_STAGE(PG8_SB(0, 0), b2, voffB); PG8_STAGE(PG8_SB(0, 1), b2 + hstep, voffB); PG8_STAGE(PG8_SA(0, 0), a2, voffA);
            PG8_WAIT_V(8); PG8_WAIT_L(0); PG8_BAR; PG8_MMA(1, 0, At, B0); PG8_MMA(1, 1, At, B1); PG8_BAR; PG8_SCHED;
            PG8_LDB(B0, 1, 0); PG8_LDB(B1, 1, 1); PG8_SCHED; PG8_LDA(At, 1, 0); PG8_STAGE(PG8_SA(0, 1), a2 + hstep, voffA);
            PG8_WAIT_V(8); PG8_WAIT_L(0); PG8_BAR; PG8_MMA(0, 0, At, B0); PG8_MMA(0, 1, At, B1); PG8_BAR; PG8_SCHED;
            PG8_LDA(At, 1, 1); PG8_STAGE(PG8_SB(1, 0), b3, voffB); PG8_STAGE(PG8_SB(1, 1), b3 + hstep, voffB); PG8_STAGE(PG8_SA(1, 0), a3, voffA);
            PG8_WAIT_V(8); PG8_WAIT_L(0); PG8_BAR; PG8_MMA(1, 0, At, B0); PG8_MMA(1, 1, At, B1); PG8_BAR; PG8_SCHED;
            } else {
            PG8_LDB(B0, 0, 0); PG8_SCHED; PG8_LDA(At, 0, 0); PG8_STAGE(PG8_SA(1, 1), a1 + hstep, voffA);
            PG8_WAIT_L(8); PG8_BAR; PG8_WAIT_L(0); PG8_MMA(0, 0, At, B0); PG8_BAR; PG8_SCHED;
            PG8_LDB(B1, 0, 1); PG8_STAGE(PG8_SB(0, 0), b2, voffB);
            PG8_BAR; PG8_WAIT_L(0); PG8_MMA(0, 1, At, B1); PG8_BAR;
            PG8_LDA(At, 0, 1); PG8_STAGE(PG8_SA(0, 0), a2, voffA);
            PG8_BAR; PG8_WAIT_L(0); PG8_MMA(1, 0, At, B0); PG8_BAR; PG8_SCHED;
            PG8_STAGE(PG8_SB(0, 1), b2 + hstep, voffB);
            PG8_WAIT_V(6); PG8_BAR; PG8_MMA(1, 1, At, B1); PG8_BAR;
            PG8_LDB(B0, 1, 0); PG8_SCHED; PG8_LDA(At, 1, 0); PG8_STAGE(PG8_SA(0, 1), a2 + hstep, voffA);
            PG8_WAIT_L(8); PG8_BAR; PG8_WAIT_L(0); PG8_MMA(0, 0, At, B0); PG8_BAR; PG8_SCHED;
            PG8_LDB(B1, 1, 1); PG8_STAGE(PG8_SB(1, 0), b3, voffB);
            PG8_BAR; PG8_WAIT_L(0); PG8_MMA(0, 1, At, B1); PG8_BAR;
            PG8_LDA(At, 1, 1); PG8_STAGE(PG8_SA(1, 0), a3, voffA);
            PG8_BAR; PG8_WAIT_L(0); PG8_MMA(1, 0, At, B0); PG8_BAR; PG8_SCHED;
            PG8_STAGE(PG8_SB(1, 1), b3 + hstep, voffB);
            PG8_WAIT_V(6); PG8_BAR; PG8_MMA(1, 1, At, B1); PG8_BAR;
            }
        }
        if constexpr (ALIGN_EPI) { if (wr == 0) PG8_BAR; }
        if constexpr (!Epi::AFTER_DRAIN) { E(acc, cur, wr, wc, fr, fq); S.done(cur); }
        if (!has_next) break;
#pragma unroll
        for (int a = 0; a < 2; ++a)
#pragma unroll
            for (int b = 0; b < 2; ++b)
#pragma unroll
                for (int m = 0; m < 4; ++m)
#pragma unroll
                    for (int n = 0; n < 2; ++n) acc[a][b][m][n] = (f32x4){0.f, 0.f, 0.f, 0.f};
        cur = nxt; cA = nA; cB = nB; ++ui;
        if constexpr (ALIGN_EPI) { if (wr == 1) PG8_BAR; }
    }
    PG8_WAIT_V(0);
    if constexpr (!ALIGN_EPI) { if (wr == 0) PG8_BAR; }
    PG8_BAR;
    if constexpr (Epi::AFTER_DRAIN) { E.fused(acc, cur, wr, wc, fr, fq, lds, wid, lane); S.done(cur); }
#undef PG8_SA
#undef PG8_SB
#undef PG8_STAGE
#undef PG8_LDA
#undef PG8_LDB
#undef PG8_MMA
#undef PG8_WAIT_V
#undef PG8_WAIT_L
#undef PG8_BAR
#undef PG8_SCHED
}
}
namespace att {
#define ATT_LAS __attribute__((address_space(3)))
typedef unsigned short bf16_t;
typedef short bf16x8 __attribute__((ext_vector_type(8)));
typedef short s16x4 __attribute__((ext_vector_type(4)));
typedef short v4i16_t __attribute__((ext_vector_type(4)));
typedef float f32x16 __attribute__((ext_vector_type(16)));
typedef float f32x4 __attribute__((ext_vector_type(4)));
typedef unsigned u32x4 __attribute__((ext_vector_type(4)));
typedef float f32x2_t __attribute__((ext_vector_type(2)));
typedef __bf16 bf16x2_t __attribute__((ext_vector_type(2)));
constexpr float NEGF = -1e30f, LOG2E = 1.4426950408889634f;
constexpr int TILE_B = 16384;
constexpr int WSF_OFF = 131072;

__device__ __forceinline__ int crow(int r, int hi) { return (r & 3) + 8 * (r >> 2) + 4 * hi; }
__device__ __forceinline__ unsigned cvtpk(float lo, float hi) { f32x2_t v = {lo, hi}; bf16x2_t b = __builtin_convertvector(v, bf16x2_t); return __builtin_bit_cast(unsigned, b); }
__device__ __forceinline__ s16x4 vtr(const ATT_LAS char* p) { return __builtin_bit_cast(s16x4, __builtin_amdgcn_ds_read_tr16_b64_v4i16((ATT_LAS v4i16_t*)p)); }
__device__ __forceinline__ float bf2f(unsigned short b) { return __builtin_bit_cast(float, (unsigned)b << 16); }

__device__ __forceinline__ void stage_write(ATT_LAS char* tile, int idx, u32x4 kv, u32x4 vv) {
    const int key = idx >> 3, ch = idx & 7;
    *(ATT_LAS u32x4*)(tile + ch * 1024 + key * 16) = kv;
    *(ATT_LAS u32x4*)(tile + 8192 + (ch >> 2) * 4096 + (key >> 4) * 1024 + (key & 15) * 64 + (ch & 3) * 16) = vv;
}

struct WS { f32x16 o0, o1; float m, l; };

__device__ __forceinline__ void tile_step(WS& s, const ATT_LAS char* tile, const bf16x8 (&qr)[4], float fd0, float slope2, float Wf, ATT_LAS float* wsf, int lane) {
    const int r32 = lane & 31, hi = lane >> 5;
    const ATT_LAS char* kb = tile + hi * 1024 + r32 * 16;
    f32x16 p0, p1;
#pragma unroll
    for (int r = 0; r < 16; ++r) { p0[r] = 0.f; p1[r] = 0.f; }
#pragma unroll
    for (int d0 = 0; d0 < 4; ++d0) {
        const bf16x8 b0 = *(const ATT_LAS bf16x8*)(kb + d0 * 2048), b1 = *(const ATT_LAS bf16x8*)(kb + d0 * 2048 + 512);
        p0 = __builtin_amdgcn_mfma_f32_32x32x16_bf16(b0, qr[d0], p0, 0, 0, 0);
        p1 = __builtin_amdgcn_mfma_f32_32x32x16_bf16(b1, qr[d0], p1, 0, 0, 0);
    }
    float mx = NEGF;
#pragma unroll
    for (int r = 0; r < 16; ++r) {
        const float c = (float)((r & 3) + 8 * (r >> 2));
        const float a0 = __builtin_fabsf(fd0 + c), a1 = __builtin_fabsf(fd0 + (c + 32.f));
        const float x0 = __builtin_fmaf(-slope2, a0, p0[r]), x1 = __builtin_fmaf(-slope2, a1, p1[r]);
        p0[r] = (a0 <= Wf) ? x0 : NEGF; p1[r] = (a1 <= Wf) ? x1 : NEGF;
        mx = __builtin_fmaxf(mx, __builtin_fmaxf(p0[r], p1[r]));
    }
    mx = __builtin_fmaxf(mx, __shfl_xor(mx, 32));
    const float mn = __builtin_fmaxf(s.m, mx);
    const float f = __builtin_amdgcn_exp2f(s.m - mn);
    s.m = mn;
    float ls = 0.f;
#pragma unroll
    for (int r = 0; r < 16; ++r) { p0[r] = __builtin_amdgcn_exp2f(p0[r] - mn); p1[r] = __builtin_amdgcn_exp2f(p1[r] - mn); ls += p0[r] + p1[r]; }
    s.l = s.l * f + ls;
    if (__any(f != 1.0f)) {
        if (hi == 0) wsf[r32] = f;
#pragma unroll
        for (int i = 0; i < 4; ++i) { const f32x4 fv = *(const ATT_LAS f32x4*)(wsf + 8 * i + 4 * hi);
#pragma unroll
            for (int j = 0; j < 4; ++j) { s.o0[4 * i + j] *= fv[j]; s.o1[4 * i + j] *= fv[j]; } }
    }
    u32x4 pw[4];
#pragma unroll
    for (int j = 0; j < 4; ++j) { pw[0][j] = cvtpk(p0[2 * j], p0[2 * j + 1]); pw[1][j] = cvtpk(p0[8 + 2 * j], p0[9 + 2 * j]); pw[2][j] = cvtpk(p1[2 * j], p1[2 * j + 1]); pw[3][j] = cvtpk(p1[8 + 2 * j], p1[9 + 2 * j]); }
    const ATT_LAS char* vb = tile + 8192 + ((lane >> 4) & 1) * 32 + (lane & 3) * 8 + (4 * hi + ((lane & 15) >> 2)) * 64;
#pragma unroll
    for (int ks = 0; ks < 4; ++ks) {
        const s16x4 l0 = vtr(vb + ks * 1024), h0 = vtr(vb + ks * 1024 + 512), l1 = vtr(vb + 4096 + ks * 1024), h1 = vtr(vb + 4096 + ks * 1024 + 512);
        const bf16x8 v0 = (bf16x8){l0[0], l0[1], l0[2], l0[3], h0[0], h0[1], h0[2], h0[3]}, v1 = (bf16x8){l1[0], l1[1], l1[2], l1[3], h1[0], h1[1], h1[2], h1[3]};
        const bf16x8 pa = __builtin_bit_cast(bf16x8, pw[ks]);
        s.o0 = __builtin_amdgcn_mfma_f32_32x32x16_bf16(pa, v0, s.o0, 0, 0, 0);
        s.o1 = __builtin_amdgcn_mfma_f32_32x32x16_bf16(pa, v1, s.o1, 0, 0, 0);
    }
}

__device__ __forceinline__ void store_o(const WS& s, float inv, bf16_t* orow0, size_t rstride, ATT_LAS float* wsf, int lane) {
    const int r32 = lane & 31, hi = lane >> 5;
    if (hi == 0) wsf[r32] = inv;
#pragma unroll
    for (int i = 0; i < 4; ++i) { const f32x4 fv = *(const ATT_LAS f32x4*)(wsf + 8 * i + 4 * hi);
#pragma unroll
        for (int j = 0; j < 4; ++j) { const int r = 4 * i + j; bf16_t* p = orow0 + (size_t)crow(r, hi) * rstride + r32;
            p[0] = (bf16_t)(cvtpk(s.o0[r] * fv[j], 0.f) & 0xffffu); p[32] = (bf16_t)(cvtpk(s.o1[r] * fv[j], 0.f) & 0xffffu); } }
}

__device__ __forceinline__ void attn_a_item(int item, const bf16_t* qkv  , bf16_t* O  , const float* sink, ATT_LAS char* lds, const int tid) {
    const int lane = tid & 63, wave = __builtin_amdgcn_readfirstlane(tid >> 6), r32 = lane & 31, hi = lane >> 5;
    const int qb = item & 31, kvh = (item >> 5) & 3, b = item >> 7;
    const int q0 = qb * 64, tok0 = b * 2048;
    ATT_LAS float* wsf = (ATT_LAS float*)(lds + WSF_OFF) + wave * 64;
    {
        u32x4 kr[5], vr[5];
#pragma unroll
        for (int j = 0; j < 5; ++j) { const int ks = q0 - 128 + 64 * j;
            if (ks >= 0 && ks < 2048) { const bf16_t* src = qkv + (size_t)(tok0 + ks + (tid >> 3)) * 1536 + 1024 + kvh * 64 + (tid & 7) * 8; kr[j] = *(const u32x4*)src; vr[j] = *(const u32x4*)(src + 256); } }
#pragma unroll
        for (int j = 0; j < 5; ++j) { const int ks = q0 - 128 + 64 * j; if (ks >= 0 && ks < 2048) stage_write(lds + j * TILE_B, tid, kr[j], vr[j]); }
    }
    const int g = wave & 3, half = wave >> 2, hq = kvh * 4 + g, qpos = q0 + 32 * half + r32;
    bf16x8 qr[4];
#pragma unroll
    for (int d0 = 0; d0 < 4; ++d0) qr[d0] = *(const bf16x8*)(qkv + (size_t)(tok0 + qpos) * 1536 + hq * 64 + d0 * 16 + hi * 8);
    const float slope2 = __builtin_amdgcn_exp2f(-0.5f * (float)(hq + 1)) * LOG2E;
    __syncthreads();
    WS s;
#pragma unroll
    for (int r = 0; r < 16; ++r) { s.o0[r] = 0.f; s.o1[r] = 0.f; }
    s.m = NEGF; s.l = 0.f;
    for (int j = 0; j < 5; ++j) { const int ks = q0 - 128 + 64 * j;
        if (ks >= 0 && ks < 2048) tile_step(s, lds + j * TILE_B, qr, (float)(ks - qpos + 4 * hi), slope2, 128.f, wsf, lane); }
    const float lt = s.l + __shfl_xor(s.l, 32);
    const float inv = 1.0f / (lt + __builtin_amdgcn_exp2f(sink[hq] * LOG2E - s.m));
    store_o(s, inv, O + (size_t)(tok0 + q0 + 32 * half) * 1024 + hq * 64, 1024, wsf, lane);
    __syncthreads();
}

__device__ __forceinline__ void attn_b_item(int item, int gi, int dil, const bf16_t* qkv  , bf16_t* O  , float* lse  , ATT_LAS char* lds, const int tid) {
    const int lane = tid & 63, wave = __builtin_amdgcn_readfirstlane(tid >> 6), r32 = lane & 31, hi = lane >> 5;
    const int hp = item & 7, within = (item >> 3) & 15, b = item >> 7;
    const int res = within % dil, qb = within / dil, L = 2048 / dil, u0 = qb * 128, tokb = b * 2048 + res;
    ATT_LAS float* wsf = (ATT_LAS float*)(lds + WSF_OFF) + wave * 64;
    {
        u32x4 kr[8], vr[8];
#pragma unroll
        for (int t = 0; t < 8; ++t) { const int j = t & 3, hh = t >> 2, ks = u0 - 64 + 64 * j;
            if (ks >= 0 && ks < L) { const bf16_t* src = qkv + (size_t)(tokb + (ks + (tid >> 3)) * dil) * 3072 + 1024 + (2 * hp + hh) * 64 + (tid & 7) * 8; kr[t] = *(const u32x4*)src; vr[t] = *(const u32x4*)(src + 1024); } }
#pragma unroll
        for (int t = 0; t < 8; ++t) { const int j = t & 3, ks = u0 - 64 + 64 * j; if (ks >= 0 && ks < L) stage_write(lds + t * TILE_B, tid, kr[t], vr[t]); }
    }
    const int hh = wave >> 2, wq = wave & 3, h = 2 * hp + hh, qpos = u0 + 32 * wq + r32;
    const size_t qtok = (size_t)(tokb + qpos * dil);
    bf16x8 qr[4];
#pragma unroll
    for (int d0 = 0; d0 < 4; ++d0) qr[d0] = *(const bf16x8*)(qkv + qtok * 3072 + h * 64 + d0 * 16 + hi * 8);
    const float slope2 = __builtin_amdgcn_exp2f(-0.5f * (float)(h + 1)) * LOG2E * (float)dil;
    bf16_t* orow0 = O + (size_t)(tokb + (u0 + 32 * wq) * dil) * 1024 + h * 64;
    const size_t rstride = (size_t)dil * 1024;
    WS s;
    if (gi == 0) {
#pragma unroll
        for (int r = 0; r < 16; ++r) { s.o0[r] = 0.f; s.o1[r] = 0.f; }
        s.m = NEGF; s.l = 0.f;
    } else {
        s.m = lse[qtok * 16 + h]; s.l = (hi == 0) ? 1.0f : 0.0f;
#pragma unroll
        for (int r = 0; r < 16; ++r) { const bf16_t* p = orow0 + (size_t)crow(r, hi) * rstride + r32; s.o0[r] = bf2f(p[0]); s.o1[r] = bf2f(p[32]); }
    }
    __syncthreads();
    for (int jj = 0; jj < 3; ++jj) { const int j = (wq >> 1) + jj, ks = u0 - 64 + 64 * j;
        if (ks >= 0 && ks < L) tile_step(s, lds + (hh * 4 + j) * TILE_B, qr, (float)(ks - qpos + 4 * hi), slope2, 64.f, wsf, lane); }
    const float lt = s.l + __shfl_xor(s.l, 32);
    if (hi == 0) lse[qtok * 16 + h] = s.m + __builtin_log2f(lt);
    store_o(s, 1.0f / lt, orow0, rstride, wsf, lane);
    __syncthreads();
}
}

#ifndef MK_MULTI
#define MK_MULTI 0
#endif
#ifndef REP_PH
#define REP_PH -1
#endif
#define LAS __attribute__((address_space(3)))
typedef unsigned short bf16;
typedef unsigned v4u __attribute__((ext_vector_type(4)));
typedef float f32x4 __attribute__((ext_vector_type(4)));
constexpr int NWAVES = 8, T = 16 * 2048, D = 1024, FF = 2816, NPH = 16;
constexpr size_t MiB = 1u << 20;
constexpr size_t WS_SSQ = 0, WS_LSE = 2 * MiB;
constexpr size_t WS_WQKVA = 4 * MiB, WS_WOA = 7 * MiB, WS_WGU0 = 9 * MiB, WS_WD0 = 20 * MiB, WS_WQKVB = 26 * MiB, WS_WOB = 44 * MiB, WS_WGU1 = 46 * MiB, WS_WD1 = 57 * MiB;
constexpr size_t WS_CTL = 63 * MiB, CTL_BYTES = 16384;
constexpr int MISC_OFF = 133120;
constexpr size_t WS_XB = 64 * MiB, WS_O = 128 * MiB, WS_BIG = 192 * MiB, WS_END = 384 * MiB;
constexpr int LDS_BYTES = 147456;

__device__ __forceinline__ unsigned f2bf(float f) { unsigned u = __builtin_bit_cast(unsigned, f); return (u + 0x7fffu + ((u >> 16) & 1u)) >> 16; }
__device__ __forceinline__ unsigned pk2(float lo, float hi) { return f2bf(lo) | (f2bf(hi) << 16); }
__device__ __forceinline__ float wave_sum(float v) {
#pragma unroll
    for (int o = 1; o < 64; o <<= 1) v += __shfl_xor(v, o);
    return v;
}
#define XB_TMO      128
#define XB_XCNT(j)  (256  + 64 * (j))
#define XB_XSUB(j)  (1280 + 64 * (j))
#define XB_XGEN(j)  (2304 + 64 * (j))
#define XB_TOP      3328
#define XB_TOPGEN   3392
#define XCD_BAR_WORDS 3456
#define XB_SPIN_CAP (1u << 18)

__device__ __forceinline__ unsigned xb_ld(unsigned* p)              { return __hip_atomic_load(p, __ATOMIC_RELAXED, __HIP_MEMORY_SCOPE_AGENT); }
__device__ __forceinline__ unsigned xb_add(unsigned* p, unsigned v) { return __hip_atomic_fetch_add(p, v, __ATOMIC_RELAXED, __HIP_MEMORY_SCOPE_AGENT); }
__device__ __forceinline__ unsigned xb_xcc_id() { return (unsigned)__builtin_amdgcn_s_getreg((3 << 11) | 20) & 0xFu; }
#define XB_SPIN(cond, bar) do { unsigned _sp = 0; while (cond) { __builtin_amdgcn_s_sleep(1); \
    if ((++_sp & 255u) == 0u) { if (xb_ld(&(bar)[XB_TMO])) break; if (_sp > XB_SPIN_CAP) { atomicAdd(&(bar)[XB_TMO], 1u); break; } } } } while (0)

struct XcdBarrier {
    unsigned* bar; unsigned x;
    volatile LAS unsigned* st;
};

__device__ __forceinline__ XcdBarrier xcd_barrier_post(unsigned* bar, volatile LAS unsigned* st) {
    XcdBarrier b; b.bar = bar; b.x = xb_xcc_id(); b.st = st;
    if (threadIdx.x == 0) (void)xb_add(&bar[XB_XCNT(b.x)], 1u);
    return b;
}
__device__ __forceinline__ void xcd_barrier_complete(unsigned* bar, unsigned x, unsigned& nloc, unsigned& nx) {
    const unsigned G = gridDim.x * gridDim.y * gridDim.z;
    unsigned sum, cnt, mine, sp = 0u;
    for (;;) {
        sum = 0u; cnt = 0u; mine = 0u;
#pragma unroll
        for (unsigned j = 0; j < 16; ++j) { const unsigned c = xb_ld(&bar[XB_XCNT(j)]); sum += c; cnt += (c > 0u) ? 1u : 0u; mine = (j == x) ? c : mine; }
        if (sum == G) break;
        __builtin_amdgcn_s_sleep(1);
        if ((++sp & 255u) == 0u) { if (xb_ld(&bar[XB_TMO])) break; if (sp > XB_SPIN_CAP) { atomicAdd(&bar[XB_TMO], 1u); break; } }
    }
    nloc = mine > 0u ? mine : 1u; nx = cnt > 0u ? cnt : 1u;
}

__device__ __forceinline__ void xcd_barrier(const XcdBarrier& b) {
    asm volatile("s_waitcnt vmcnt(0)" ::: "memory");
    __syncthreads();
    if (threadIdx.x == 0) {
        unsigned* bar = b.bar;
        __builtin_amdgcn_s_waitcnt(0);
        unsigned nloc = b.st[0], nx = b.st[1];
        if (nloc == 0u) { xcd_barrier_complete(bar, b.x, nloc, nx); b.st[0] = nloc; b.st[1] = nx; }
        const unsigned old = xb_add(&bar[XB_XSUB(b.x)], 1u);
        const unsigned gen = old / nloc;
        if (old + 1u == (gen + 1u) * nloc) {
            __builtin_amdgcn_fence(__ATOMIC_RELEASE, "agent");
            asm volatile("s_waitcnt vmcnt(0)" ::: "memory");
            const unsigned og = xb_add(&bar[XB_TOP], 1u);
            const unsigned tg = og / nx;
            if (og + 1u == (tg + 1u) * nx) xb_add(&bar[XB_TOPGEN], 1u);
            else XB_SPIN(xb_ld(&bar[XB_TOPGEN]) == tg, bar);
            __builtin_amdgcn_fence(__ATOMIC_ACQUIRE, "agent");
            xb_add(&bar[XB_XGEN(b.x)], 1u);
            asm volatile("s_waitcnt vmcnt(0)" ::: "memory");
        } else {
            XB_SPIN(xb_ld(&bar[XB_XGEN(b.x)]) == gen, bar);
            __builtin_amdgcn_fence(__ATOMIC_ACQUIRE, "agent");
            asm volatile("s_waitcnt vmcnt(0)" ::: "memory");
        }
    }
    __syncthreads();
}

__device__ __forceinline__ void transpose_item(const float* W, int K, int N, bf16* WT, const float* gs, int mode, LAS float* scr, int item, int lane) {
    const int nblk = N / 32, kb = item / nblk, nb = item % nblk, k0 = 64 * kb, n0 = 32 * nb;
#pragma unroll 8
    for (int i = 0; i < 32; ++i) { const int kk = 2 * i + (lane >> 5); const float sc = gs ? gs[k0 + kk] : 1.0f; scr[kk * 33 + (lane & 31)] = W[(size_t)(k0 + kk) * N + n0 + (lane & 31)] * sc; }
    asm volatile("s_waitcnt lgkmcnt(0)" ::: "memory");
    const int c = lane & 7;
    const int rbase = (mode == 0) ? n0 : (256 * (n0 >> 7) + (n0 & 127) + (mode == 2 ? 128 : 0));
#pragma unroll
    for (int j = 0; j < 4; ++j) { const int n = (lane >> 3) + 8 * j; const LAS float* s = scr + (8 * c) * 33 + n;
        v4u o; o.x = pk2(s[0 * 33], s[1 * 33]); o.y = pk2(s[2 * 33], s[3 * 33]); o.z = pk2(s[4 * 33], s[5 * 33]); o.w = pk2(s[6 * 33], s[7 * 33]);
        *(v4u*)(WT + (size_t)(rbase + n) * K + k0 + 8 * c) = o; }
    asm volatile("s_waitcnt lgkmcnt(0)" ::: "memory");
}

struct Args { const float* in[12]; float* out; unsigned char* ws; int ph_lo, ph_hi; };

__global__ void __launch_bounds__(NWAVES * 64, 2) fwd_megakernel(Args a) {
    extern __shared__ __attribute__((aligned(16))) unsigned char lds_raw[];
    LAS unsigned char* lds = (LAS unsigned char*)lds_raw;
    cg::grid_group grid = cg::this_grid();
    const int G = gridDim.x, bid = blockIdx.x;
    unsigned char* ws = a.ws;
    float* ssqp = (float*)(ws + WS_SSQ); float* lse = (float*)(ws + WS_LSE);
    bf16* XB = (bf16*)(ws + WS_XB); bf16* OB = (bf16*)(ws + WS_O); bf16* BIG = (bf16*)(ws + WS_BIG);
    const int NGW = G * NWAVES;
    if (threadIdx.x < 2) ((volatile LAS unsigned*)(lds + MISC_OFF))[threadIdx.x] = 0u;
    __syncthreads();
    XcdBarrier bar = xcd_barrier_post((unsigned*)(ws + WS_CTL), (volatile LAS unsigned*)(lds + MISC_OFF));

    bool rep_done = false;
    for (int ph = a.ph_lo; ph < a.ph_hi; ++ph) {
        int tid = threadIdx.x; asm volatile("" : "+v"(tid));
        const int lane = tid & 63, wave = __builtin_amdgcn_readfirstlane(tid >> 6), gw = bid * NWAVES + wave;
        if (ph == 0) {
            LAS float* scr = (LAS float*)(lds + wave * 16384);
            constexpr int I_QA = 16 * 48, I_O = 16 * 32, I_G = 16 * 88, I_D = 44 * 32, I_QB = 16 * 288;
            constexpr int NITEMS = I_QA + 2 * I_O + 4 * I_G + 2 * I_D + I_QB;
            for (int it = gw; it < NITEMS; it += NGW) {
                int r = it;
                if (r < I_QA) { transpose_item(a.in[3], D, 1536, (bf16*)(ws + WS_WQKVA), a.in[1], 0, scr, r, lane); continue; } r -= I_QA;
                if (r < I_O) { transpose_item(a.in[4], D, D, (bf16*)(ws + WS_WOA), nullptr, 0, scr, r, lane); continue; } r -= I_O;
                if (r < I_O) { transpose_item(a.in[7], D, D, (bf16*)(ws + WS_WOB), nullptr, 0, scr, r, lane); continue; } r -= I_O;
                if (r < I_G) { transpose_item(a.in[8], D, FF, (bf16*)(ws + WS_WGU0), a.in[2], 1, scr, r, lane); continue; } r -= I_G;
                if (r < I_G) { transpose_item(a.in[9], D, FF, (bf16*)(ws + WS_WGU0), a.in[2], 2, scr, r, lane); continue; } r -= I_G;
                if (r < I_G) { transpose_item(a.in[8] + (size_t)D * FF, D, FF, (bf16*)(ws + WS_WGU1), a.in[2] + D, 1, scr, r, lane); continue; } r -= I_G;
                if (r < I_G) { transpose_item(a.in[9] + (size_t)D * FF, D, FF, (bf16*)(ws + WS_WGU1), a.in[2] + D, 2, scr, r, lane); continue; } r -= I_G;
                if (r < I_D) { transpose_item(a.in[10], FF, D, (bf16*)(ws + WS_WD0), nullptr, 0, scr, r, lane); continue; } r -= I_D;
                if (r < I_D) { transpose_item(a.in[10] + (size_t)FF * D, FF, D, (bf16*)(ws + WS_WD1), nullptr, 0, scr, r, lane); continue; } r -= I_D;
                transpose_item(a.in[6], D, 9216, (bf16*)(ws + WS_WQKVB), a.in[1] + D, 0, scr, r, lane);
            }
            for (int m = gw; m < T; m += NGW) {
                const f32x4* xr = (const f32x4*)(a.in[0] + (size_t)m * D) + lane;
                f32x4 v[4]; float s = 0.f;
#pragma unroll
                for (int j = 0; j < 4; ++j) { v[j] = xr[64 * j]; s += (v[j].x * v[j].x + v[j].y * v[j].y) + (v[j].z * v[j].z + v[j].w * v[j].w); }
                s = wave_sum(s);
                unsigned long long* o8 = (unsigned long long*)(XB + (size_t)m * D) + lane;
#pragma unroll
                for (int j = 0; j < 4; ++j) o8[64 * j] = (unsigned long long)pk2(v[j].x, v[j].y) | ((unsigned long long)pk2(v[j].z, v[j].w) << 32);
                if (lane < 16) ssqp[(size_t)m * 16 + lane] = (lane == 0) ? s : 0.f;
            }
            __syncthreads();
        } else if (ph == 1 || ph == 6 || ph == 8 || ph == 10) {
            const int gi = (ph - 6) >> 1;
            const int N = (ph == 1) ? 1536 : 3072;
            const bf16* Bt = (ph == 1) ? (const bf16*)(ws + WS_WQKVA) : (const bf16*)(ws + WS_WQKVB) + (size_t)gi * 3072 * D;
            pg8::Gemm g{XB, Bt, T, N, D}; pg8::StaticOrder S; S.init(T, N, G, bid);
            pg8::EpiQKV E{BIG, N, ssqp, 4};
#ifndef DIS_QKV
            pg8::gemm_phase<pg8::EpiQKV, pg8::StaticOrder, true, true>(lds, g, S, E, tid);
#endif
        } else if (ph == 2) {
#ifndef DIS_ATTA
            for (int it = bid; it < 2048; it += G) att::attn_a_item(it, BIG, OB, a.in[5], (LAS char*)lds, tid);
#endif
        } else if (ph == 7 || ph == 9 || ph == 11) {
            const int gi = (ph - 7) >> 1, dil = (gi == 0) ? 1 : (gi == 1 ? 4 : 16);
#ifndef DIS_ATTB
            for (int it = bid; it < 2048; it += G) att::attn_b_item(it, gi, dil, BIG, OB, lse, (LAS char*)lds, tid);
#endif
        } else if (ph == 3 || ph == 5 || ph == 12 || ph == 14) {
            const bool down = (ph == 5 || ph == 14);
            const bf16* A = down ? BIG : OB;
            const bf16* Bt = (const bf16*)(ws + (ph == 3 ? WS_WOA : ph == 5 ? WS_WD0 : ph == 12 ? WS_WOB : WS_WD1));
            pg8::Gemm g{A, Bt, T, D, down ? FF : D}; pg8::StaticOrder S; S.init(T, D, G, bid);
            pg8::EpiResid E{XB, ssqp};
#ifndef DIS_RES
            pg8::gemm_phase<pg8::EpiResid, pg8::StaticOrder, true, true>(lds, g, S, E, tid);
#endif
        } else if (ph == 4 || ph == 13) {
            const bf16* Bt = (const bf16*)(ws + (ph == 4 ? WS_WGU0 : WS_WGU1));
            pg8::Gemm g{XB, Bt, T, 2 * FF, D}; pg8::StaticOrder S; S.init(T, 2 * FF, G, bid);
            pg8::EpiSwiGLU E{BIG, ssqp};
#ifndef DIS_SWI
            pg8::gemm_phase<pg8::EpiSwiGLU, pg8::StaticOrder, true, true>(lds, g, S, E, tid);
#endif
        } else {
            const float* gf = a.in[11];
            for (int m = gw; m < T; m += NGW) {
                float s = (lane < 16) ? ssqp[(size_t)m * 16 + lane] : 0.f;
                s = wave_sum(s);
                const float r = rsqrtf(s * (1.0f / 1024.0f) + 1e-6f);
                const unsigned long long* xr = (const unsigned long long*)(XB + (size_t)m * D) + lane;
                f32x4* orow = (f32x4*)(a.out + (size_t)m * D) + lane;
#pragma unroll
                for (int j = 0; j < 4; ++j) { const f32x4 gv = ((const f32x4*)gf)[lane + 64 * j]; const unsigned long long w = xr[64 * j]; const unsigned lo = (unsigned)w, hi = (unsigned)(w >> 32);
                    f32x4 v; v.x = __builtin_bit_cast(float, lo << 16); v.y = __builtin_bit_cast(float, lo & 0xffff0000u); v.z = __builtin_bit_cast(float, hi << 16); v.w = __builtin_bit_cast(float, hi & 0xffff0000u);
                    orow[64 * j] = v * r * gv; }
            }
        }
        if (ph + 1 < a.ph_hi) {
            if (ph == 0) { __threadfence(); grid.sync(); __builtin_amdgcn_fence(__ATOMIC_ACQUIRE, "agent"); }
            else xcd_barrier(bar);
        }
        if (REP_PH >= 0 && ph == REP_PH && !rep_done) { rep_done = true; --ph; }
    }
}

extern "C" void kernel_launch(void* const* d_in, const int* in_sizes, int n_in, void* d_out, int out_size, void* d_ws, size_t ws_size, hipStream_t stream) {
    static int grid = 0;
    if (grid == 0) {
        int dev = 0, cus = 0, per_cu = 0;
        if (n_in != 12 || out_size != T * D || ws_size < WS_END) { fprintf(stderr, "kernel_launch: unexpected shapes (n_in %d out %d ws %zu)\n", n_in, out_size, ws_size); grid = -1; return; }
        hipGetDevice(&dev);
        hipDeviceGetAttribute(&cus, hipDeviceAttributeMultiprocessorCount, dev);
        if (hipFuncSetAttribute((const void*)fwd_megakernel, hipFuncAttributeMaxDynamicSharedMemorySize, LDS_BYTES) != hipSuccess) { fprintf(stderr, "kernel_launch: hipFuncSetAttribute failed\n"); grid = -1; return; }
        if (hipOccupancyMaxActiveBlocksPerMultiprocessor(&per_cu, (const void*)fwd_megakernel, NWAVES * 64, LDS_BYTES) != hipSuccess || per_cu < 1) { fprintf(stderr, "kernel_launch: occupancy query says %d\n", per_cu); per_cu = 1; }
        (void)hipGetLastError();
        grid = cus;
        fprintf(stderr, "kernel_launch: grid %d (per_cu %d)\n", grid, per_cu);
    }
    if (grid < 0) return;
    if (hipMemsetAsync((char*)d_ws + WS_CTL, 0, CTL_BYTES, stream) != hipSuccess) { fprintf(stderr, "kernel_launch: memset failed\n"); return; }
    Args a{};
    for (int i = 0; i < 12; ++i) a.in[i] = (const float*)d_in[i];
    a.out = (float*)d_out; a.ws = (unsigned char*)d_ws;
#if MK_MULTI
    for (int ph = 0; ph < NPH; ++ph) {
        a.ph_lo = ph; a.ph_hi = ph + 1;
        void* args[] = {&a};
        hipError_t e = hipLaunchCooperativeKernel((const void*)fwd_megakernel, dim3(grid), dim3(NWAVES * 64), args, LDS_BYTES, stream);
        if (e != hipSuccess) { fprintf(stderr, "launch %d failed: %s\n", ph, hipGetErrorString(e)); break; }
    }
#else
    a.ph_lo = 0; a.ph_hi = NPH;
    void* args[] = {&a};
    hipError_t e = hipLaunchCooperativeKernel((const void*)fwd_megakernel, dim3(grid), dim3(NWAVES * 64), args, LDS_BYTES, stream);
    if (e != hipSuccess) fprintf(stderr, "cooperative launch failed: %s (grid %d)\n", hipGetErrorString(e), grid);
#endif
}
```

```cpp
#include <hip/hip_runtime.h>
#include <hip/hip_cooperative_groups.h>
#include <cstdio>
#include <cstdint>
namespace cg = cooperative_groups;
namespace pg8 {
#define PG8_LAS __attribute__((address_space(3)))
typedef unsigned short bf16_t;
typedef short bf16x8 __attribute__((ext_vector_type(8)));
typedef float f32x4 __attribute__((ext_vector_type(4)));
typedef unsigned u32x4 __attribute__((ext_vector_type(4)));
constexpr int BM = 256, BK = 64, HALF = 128, HTB = HALF * BK * 2  , STAGE_BYTES = 8 * HTB, NXCD = 8, WGM = 8;

__host__ __device__ __forceinline__ int lds_byte(int r, int c) { const int st = (r >> 4) * 2 + (c >> 5), rr = r & 15, cc = c & 31, ob = rr * 64 + cc * 2; return st * 1024 + (ob ^ (((ob >> 9) & 1) << 5)); }
__host__ __device__ __forceinline__ void stage_rc(int b, int& R, int& C) { const int st = b / 1024, sb = b % 1024, swz = sb ^ (((sb >> 9) & 1) << 5); R = (st >> 1) * 16 + swz / 64; C = (st & 1) * 32 + (swz % 64) / 2; }
__host__ __device__ __forceinline__ int perm32(int rho) { const int n = rho >> 4, i = rho & 15; return 8 * (i >> 2) + 4 * n + (i & 3); }

struct Unit { int pm, pn; };
struct Gemm { const bf16_t* A; const bf16_t* Bt; int M, N, K; };

struct StaticOrder {
    int nM, nN, nwg, G, c;
    __host__ __device__ void init(int M, int N, int G_, int c_) { nM = M / BM; nN = N / BM; nwg = nM * nN; G = G_; c = c_; }
    __host__ __device__ bool next(int i, Unit& u) const {
        const long L = (long)i * G + c; if (L >= nwg) return false;
        int wgid = (int)L; { const int q = nwg / NXCD, r = nwg % NXCD, xcd = wgid % NXCD, off = wgid / NXCD; wgid = (xcd < r ? xcd * (q + 1) : r * (q + 1) + (xcd - r) * q) + off; }
        const int nig = WGM * nN, gid = wgid / nig, fm = gid * WGM, gsz = (nM - fm) < WGM ? (nM - fm) : WGM;
        u.pm = fm + ((wgid % nig) % gsz); u.pn = (wgid % nig) / gsz; return true;
    }
    __device__ __forceinline__ void a_ready(const Unit&) const {}
    __device__ __forceinline__ void done(const Unit&) const {}
};

__device__ __forceinline__ unsigned cvt_pk_bf16(float lo, float hi) { unsigned r; asm volatile("v_cvt_pk_bf16_f32 %0, %1, %2" : "=v"(r) : "v"(lo), "v"(hi)); return r; }
constexpr float RMS_EPS_F = 1e-6f;
constexpr float QK_C2 = 0.125f * 1.4426950408889634f;
__device__ __forceinline__ float row_rscale(const float* ssqp, int row, int fq) {
    const f32x4 p = *(const f32x4*)(ssqp + (size_t)row * 16 + 4 * fq);
    float s = (p[0] + p[1]) + (p[2] + p[3]);
    s += __shfl_xor(s, 16); s += __shfl_xor(s, 32);
    return rsqrtf(s * (1.0f / 1024.0f) + RMS_EPS_F);
}
struct EpiQKV {
    static constexpr bool PERM = true, AFTER_DRAIN = false;
    bf16_t* O; int ldc; const float* ssqp; int qtiles;
    __device__ __forceinline__ void operator()(const f32x4 (&acc)[2][2][4][2], const Unit& u, int wr, int wc, int fr, int fq) const {
        const int row0 = u.pm * BM + wr * 64 + fr, col0 = u.pn * BM + wc * 32 + 8 * fq;
        const float sc = (u.pn < qtiles) ? QK_C2 : 1.0f;
#pragma unroll
        for (int ai = 0; ai < 2; ++ai)
#pragma unroll
            for (int m = 0; m < 4; ++m) { const int row = row0 + ai * HALF + m * 16; const float r = row_rscale(ssqp, row, fq) * sc;
                bf16_t* rowp = O + (size_t)row * ldc + col0;
#pragma unroll
                for (int bj = 0; bj < 2; ++bj) { const f32x4 v0 = acc[ai][bj][m][0] * r, v1 = acc[ai][bj][m][1] * r;
                    u32x4 w; w.x = cvt_pk_bf16(v0[0], v0[1]); w.y = cvt_pk_bf16(v0[2], v0[3]); w.z = cvt_pk_bf16(v1[0], v1[1]); w.w = cvt_pk_bf16(v1[2], v1[3]);
                    *(u32x4*)(rowp + bj * HALF) = w; } }
    }
};
struct EpiResid {
    static constexpr bool PERM = true, AFTER_DRAIN = false;
    bf16_t* xb; float* ssqp_out;
    __device__ __forceinline__ void operator()(const f32x4 (&acc)[2][2][4][2], const Unit& u, int wr, int wc, int fr, int fq) const {
        const int row0 = u.pm * BM + wr * 64 + fr, col0 = u.pn * BM + wc * 32 + 8 * fq;
#pragma unroll
        for (int ai = 0; ai < 2; ++ai)
#pragma unroll
            for (int m = 0; m < 4; ++m) { const int row = row0 + ai * HALF + m * 16; const size_t off = (size_t)row * 1024 + col0; float ss = 0.f;
#pragma unroll
                for (int bj = 0; bj < 2; ++bj) {
                    const u32x4 b = *(const u32x4*)(xb + off + bj * HALF);
                    f32x4 v0 = acc[ai][bj][m][0], v1 = acc[ai][bj][m][1];
                    v0[0] += __builtin_bit_cast(float, b.x << 16); v0[1] += __builtin_bit_cast(float, b.x & 0xffff0000u); v0[2] += __builtin_bit_cast(float, b.y << 16); v0[3] += __builtin_bit_cast(float, b.y & 0xffff0000u);
                    v1[0] += __builtin_bit_cast(float, b.z << 16); v1[1] += __builtin_bit_cast(float, b.z & 0xffff0000u); v1[2] += __builtin_bit_cast(float, b.w << 16); v1[3] += __builtin_bit_cast(float, b.w & 0xffff0000u);
                    u32x4 w; w.x = cvt_pk_bf16(v0[0], v0[1]); w.y = cvt_pk_bf16(v0[2], v0[3]); w.z = cvt_pk_bf16(v1[0], v1[1]); w.w = cvt_pk_bf16(v1[2], v1[3]);
                    *(u32x4*)(xb + off + bj * HALF) = w;
                    ss += (v0[0] * v0[0] + v0[1] * v0[1]) + (v0[2] * v0[2] + v0[3] * v0[3]) + (v1[0] * v1[0] + v1[1] * v1[1]) + (v1[2] * v1[2] + v1[3] * v1[3]); }
                ss += __shfl_xor(ss, 16); ss += __shfl_xor(ss, 32);
                if (fq == 0) ssqp_out[(size_t)row * 16 + u.pn * 4 + wc] = ss; }
    }
};
struct EpiSwiGLU {
    static constexpr bool PERM = true, AFTER_DRAIN = false;
    bf16_t* H; const float* ssqp;
    __device__ __forceinline__ void operator()(const f32x4 (&acc)[2][2][4][2], const Unit& u, int wr, int wc, int fr, int fq) const {
        const int row0 = u.pm * BM + wr * 64 + fr, hcol = u.pn * HALF + wc * 32 + 8 * fq;
#pragma unroll
        for (int ai = 0; ai < 2; ++ai)
#pragma unroll
            for (int m = 0; m < 4; ++m) { const int row = row0 + ai * HALF + m * 16; const float r = row_rscale(ssqp, row, fq);
                float hv[8];
#pragma unroll
                for (int n = 0; n < 2; ++n)
#pragma unroll
                    for (int j = 0; j < 4; ++j) { const float g = acc[ai][0][m][n][j] * r, up = acc[ai][1][m][n][j] * r;
                        const float sg = g * __builtin_amdgcn_rcpf(1.0f + __builtin_amdgcn_exp2f(-1.4426950408889634f * g)); hv[n * 4 + j] = sg * up; }
                u32x4 w; w.x = cvt_pk_bf16(hv[0], hv[1]); w.y = cvt_pk_bf16(hv[2], hv[3]); w.z = cvt_pk_bf16(hv[4], hv[5]); w.w = cvt_pk_bf16(hv[6], hv[7]);
                *(u32x4*)(H + (size_t)row * 2816 + hcol) = w; }
    }
};

template <class Epi, class Sched, bool ALIGN_EPI = false, bool SP2 = false>
__device__ __forceinline__ void gemm_phase(PG8_LAS unsigned char* lds, const Gemm g, const Sched& S, const Epi& E, const int tid) {
    const int wid = __builtin_amdgcn_readfirstlane(tid >> 6), lane = tid & 63, wr = wid >> 2, wc = wid & 3, fr = lane & 15, fq = lane >> 4;
    const int K = g.K, nt = K / BK;
    unsigned voffA[2], voffB[2];
#pragma unroll
    for (int i = 0; i < 2; ++i) { int R, C; stage_rc(tid * 16 + i * 8192, R, C); const int Rb = Epi::PERM ? ((R & ~31) + perm32(R & 31)) : R;
        voffA[i] = (unsigned)(R * K + C) * 2u; voffB[i] = (unsigned)(Rb * K + C) * 2u; }
    const size_t kstep = (size_t)(BK * 2);
    const size_t hstep = (size_t)HALF * K * 2;
    const size_t tstep = 2 * hstep;
    const unsigned ldsw = (unsigned)wid * 1024u;
    const int aoff = lds_byte(wr * 64 + fr, fq * 8), boff = lds_byte(wc * 32 + fr, fq * 8);
#define PG8_SA(b, h) (((b) * 2 + (h)) * HTB)
#define PG8_SB(b, h) ((4 + (b) * 2 + (h)) * HTB)
#define PG8_STAGE(bufoff, gbase, voff) do { _Pragma("unroll") for (int _i = 0; _i < 2; ++_i) \
        __builtin_amdgcn_global_load_lds((const unsigned*)((const char*)(gbase) + (voff)[_i]), (PG8_LAS unsigned*)(lds + (bufoff) + ldsw + _i * 8192), 16, 0, 0); } while (0)
#define PG8_LDA(dst, b, h) do { _Pragma("unroll") for (int m = 0; m < 4; ++m) _Pragma("unroll") for (int k = 0; k < 2; ++k) dst[m][k] = *(const PG8_LAS bf16x8*)(lds + PG8_SA(b, h) + aoff + m * 2048 + k * 1024); } while (0)
#define PG8_LDB(dst, b, h) do { _Pragma("unroll") for (int n = 0; n < 2; ++n) _Pragma("unroll") for (int k = 0; k < 2; ++k) dst[n][k] = *(const PG8_LAS bf16x8*)(lds + PG8_SB(b, h) + boff + n * 2048 + k * 1024); } while (0)
#define PG8_MMA(ai, bj, At, Bt) do { __builtin_amdgcn_s_setprio(1); _Pragma("unroll") for (int m = 0; m < 4; ++m) _Pragma("unroll") for (int n = 0; n < 2; ++n) _Pragma("unroll") for (int k = 0; k < 2; ++k) \
        acc[ai][bj][m][n] = __builtin_amdgcn_mfma_f32_16x16x32_bf16(Bt[n][k], At[m][k], acc[ai][bj][m][n], 0, 0, 0); __builtin_amdgcn_s_setprio(0); } while (0)
#define PG8_WAIT_V(n) asm volatile("s_waitcnt vmcnt(" #n ")" ::: "memory")
#define PG8_WAIT_L(n) asm volatile("s_waitcnt lgkmcnt(" #n ")" ::: "memory")
#define PG8_BAR __builtin_amdgcn_s_barrier()
#define PG8_SCHED __builtin_amdgcn_sched_barrier(0)
    Unit cur, nxt; int ui = 0;
    if (!S.next(0, cur)) return;
    f32x4 acc[2][2][4][2];
#pragma unroll
    for (int a = 0; a < 2; ++a)
#pragma unroll
        for (int b = 0; b < 2; ++b)
#pragma unroll
            for (int m = 0; m < 4; ++m)
#pragma unroll
                for (int n = 0; n < 2; ++n) acc[a][b][m][n] = (f32x4){0.f, 0.f, 0.f, 0.f};
    bf16x8 At[4][2], B0[2][2], B1[2][2];
    const char* cA = (const char*)g.A + (size_t)cur.pm * tstep; const char* cB = (const char*)g.Bt + (size_t)cur.pn * tstep;
    S.a_ready(cur);
    if constexpr (SP2) {
        PG8_STAGE(PG8_SB(0, 0), cB, voffB); PG8_STAGE(PG8_SB(0, 1), cB + hstep, voffB); PG8_STAGE(PG8_SA(0, 0), cA, voffA); PG8_STAGE(PG8_SA(0, 1), cA + hstep, voffA);
        if (wr == 1) PG8_BAR;
        PG8_WAIT_V(2); PG8_BAR;
        PG8_STAGE(PG8_SB(1, 0), cB + kstep, voffB); PG8_STAGE(PG8_SA(1, 0), cA + kstep, voffA); PG8_STAGE(PG8_SB(1, 1), cB + hstep + kstep, voffB);
        PG8_WAIT_V(6); PG8_BAR;
    } else {
        PG8_STAGE(PG8_SB(0, 0), cB, voffB); PG8_STAGE(PG8_SA(0, 0), cA, voffA); PG8_STAGE(PG8_SB(0, 1), cB + hstep, voffB); PG8_STAGE(PG8_SA(0, 1), cA + hstep, voffA);
        if (wr == 1) PG8_BAR;
        PG8_WAIT_V(4); PG8_BAR;
        PG8_STAGE(PG8_SB(1, 0), cB + kstep, voffB); PG8_STAGE(PG8_SA(1, 0), cA + kstep, voffA); PG8_STAGE(PG8_SB(1, 1), cB + hstep + kstep, voffB);
        PG8_WAIT_V(6); PG8_BAR;
    }
    for (;;) {
        const bool has_next = S.next(ui + 1, nxt);
        const char* nA = has_next ? (const char*)g.A + (size_t)nxt.pm * tstep : cA; const char* nB = has_next ? (const char*)g.Bt + (size_t)nxt.pn * tstep : cB;
        for (int t = 0; t < nt; t += 2) {
            const bool last = (t == nt - 2);
            const char* a1 = cA + (size_t)(t + 1) * kstep;
            const char* a2 = last ? nA : cA + (size_t)(t + 2) * kstep; const char* b2 = last ? nB : cB + (size_t)(t + 2) * kstep;
            const char* a3 = a2 + kstep; const char* b3 = b2 + kstep;
            if (last && has_next) S.a_ready(nxt);
            if constexpr (SP2) {
            PG8_LDB(B0, 0, 0); PG8_LDB(B1, 0, 1); PG8_SCHED; PG8_LDA(At, 0, 0); PG8_STAGE(PG8_SA(1, 1), a1 + hstep, voffA);
            PG8_WAIT_V(8); PG8_WAIT_L(0); PG8_BAR; PG8_MMA(0, 0, At, B0); PG8_MMA(0, 1, At, B1); PG8_BAR; PG8_SCHED;
            PG8_LDA(At, 0, 1); PG8_STAGE(PG8_SB(0, 0), b2, voffB); PG8_STAGE(PG8_SB(0, 1), b2 + hstep, voffB); PG8_STAGE(PG8_SA(0, 0), a2, voffA);
            PG8_WAIT_V(8); PG8_WAIT_L(0); PG8_BAR; PG8_MMA(1, 0, At, B0); PG8_MMA(1, 1, At, B1); PG8_BAR; PG8_SCHED;
            PG8_LDB(B0, 1, 0); PG8_LDB(B1, 1, 1); PG8_SCHED; PG8_LDA(At, 1, 0); PG8_STAGE(PG8_SA(0, 1), a2 + hstep, voffA);
            PG8_WAIT_V(8); PG8_WAIT_L(0); PG8_BAR; PG8_MMA(0, 0, At, B0); PG8_MMA(0, 1, At, B1); PG8_BAR; PG8_SCHED;
            PG8_LDA(At, 1, 1); PG8_STAGE(PG8_SB(1, 0), b3, voffB); PG8_STAGE(PG8_SB(1, 1), b3 + hstep, voffB); PG8_STAGE(PG8_SA(1, 0), a3, voffA);
            PG8_WAIT_V(8); PG8_WAIT_L(0); PG8_BAR; PG8_MMA(1, 0, At, B0); PG8_MMA(1, 1, At, B1); PG8_BAR; PG8_SCHED;
            } else {
            PG8_LDB(B0, 0, 0); PG8_SCHED; PG8_LDA(At, 0, 0); PG8_STAGE(PG8_SA(1, 1), a1 + hstep, voffA);
            PG8_WAIT_L(8); PG8_BAR; PG8_WAIT_L(0); PG8_MMA(0, 0, At, B0); PG8_BAR; PG8_SCHED;
            PG8_LDB(B1, 0, 1); PG8_STAGE(PG8_SB(0, 0), b2, voffB);
            PG8_BAR; PG8_WAIT_L(0); PG8_MMA(0, 1, At, B1); PG8_BAR;
            PG8_LDA(At, 0, 1); PG8_STAGE(PG8_SA(0, 0), a2, voffA);
            PG8_BAR; PG8_WAIT_L(0); PG8_MMA(1, 0, At, B0); PG8_BAR; PG8_SCHED;
            PG8_STAGE(PG8_SB(0, 1), b2 + hstep, voffB);
            PG8_WAIT_V(6); PG8_BAR; PG8_MMA(1, 1, At, B1); PG8_BAR;
            PG8_LDB(B0, 1, 0); PG8_SCHED; PG8_LDA(At, 1, 0); PG8_STAGE(PG8_SA(0, 1), a2 + hstep, voffA);
            PG8_WAIT_L(8); PG8_BAR; PG8_WAIT_L(0); PG8_MMA(0, 0, At, B0); PG8_BAR; PG8_SCHED;
            PG8_LDB(B1, 1, 1); PG8_STAGE(PG8_SB(1, 0), b3, voffB);
            PG8_BAR; PG8_WAIT_L(0); PG8_MMA(0, 1, At, B1); PG8_BAR;
            PG8_LDA(At, 1, 1); PG8_STAGE(PG8_SA(1, 0), a3, voffA);
            PG8_BAR; PG8_WAIT_L(0); PG8_MMA(1, 0, At, B0); PG8_BAR; PG8_SCHED;
            PG8_STAGE(PG8_SB(1, 1), b3 + hstep, voffB);
            PG8_WAIT_V(6); PG8_BAR; PG8_MMA(1, 1, At, B1); PG8_BAR;
            }
        }
        if constexpr (ALIGN_EPI) { if (wr == 0) PG8_BAR; }
        if constexpr (!Epi::AFTER_DRAIN) { E(acc, cur, wr, wc, fr, fq); S.done(cur); }
        if (!has_next) break;
#pragma unroll
        for (int a = 0; a < 2; ++a)
#pragma unroll
            for (int b = 0; b < 2; ++b)
#pragma unroll
                for (int m = 0; m < 4; ++m)
#pragma unroll
                    for (int n = 0; n < 2; ++n) acc[a][b][m][n] = (f32x4){0.f, 0.f, 0.f, 0.f};
        cur = nxt; cA = nA; cB = nB; ++ui;
        if constexpr (ALIGN_EPI) { if (wr == 1) PG8_BAR; }
    }
    PG8_WAIT_V(0);
    if constexpr (!ALIGN_EPI) { if (wr == 0) PG8_BAR; }
    PG8_BAR;
    if constexpr (Epi::AFTER_DRAIN) { E.fused(acc, cur, wr, wc, fr, fq, lds, wid, lane); S.done(cur); }
#undef PG8_SA
#undef PG8_SB
#undef PG8_STAGE
#undef PG8_LDA
#undef PG8_LDB
#undef PG8_MMA
#undef PG8_WAIT_V
#undef PG8_WAIT_L
#undef PG8_BAR
#undef PG8_SCHED
}
}
namespace att {
#define ATT_LAS __attribute__((address_space(3)))
typedef unsigned short bf16_t;
typedef short bf16x8 __attribute__((ext_vector_type(8)));
typedef short s16x4 __attribute__((ext_vector_type(4)));
typedef short v4i16_t __attribute__((ext_vector_type(4)));
typedef float f32x16 __attribute__((ext_vector_type(16)));
typedef float f32x4 __attribute__((ext_vector_type(4)));
typedef unsigned u32x4 __attribute__((ext_vector_type(4)));
typedef float f32x2_t __attribute__((ext_vector_type(2)));
typedef __bf16 bf16x2_t __attribute__((ext_vector_type(2)));
typedef ATT_LAS unsigned ATT_LAS_U; typedef ATT_LAS char ATT_LAS_C; typedef ATT_LAS float ATT_LAS_F;
constexpr float NEGF = -1e30f, LOG2E = 1.4426950408889634f;
constexpr int TILE_B = 16384;
constexpr int WSF_OFF = 131072;

__device__ __forceinline__ int crow(int r, int hi) { return (r & 3) + 8 * (r >> 2) + 4 * hi; }
__device__ __forceinline__ unsigned cvtpk(float lo, float hi) { f32x2_t v = {lo, hi}; bf16x2_t b = __builtin_convertvector(v, bf16x2_t); return __builtin_bit_cast(unsigned, b); }
__device__ __forceinline__ s16x4 vtr(const ATT_LAS char* p) { return __builtin_bit_cast(s16x4, __builtin_amdgcn_ds_read_tr16_b64_v4i16((ATT_LAS v4i16_t*)p)); }
__device__ __forceinline__ float bf2f(unsigned short b) { return __builtin_bit_cast(float, (unsigned)b << 16); }

__device__ __forceinline__ void stage_write(ATT_LAS char* tile, int idx, u32x4 kv, u32x4 vv) {
    const int key = idx >> 3, ch = idx & 7;
    *(ATT_LAS u32x4*)(tile + ch * 1024 + ((key + ch) & 63) * 16) = kv;
    *(ATT_LAS u32x4*)(tile + 8192 + (ch >> 2) * 4096 + (key >> 4) * 1024 + (key & 15) * 64 + (ch & 3) * 16) = vv;
}

struct WS { f32x16 o0, o1; float m, l; };

__device__ __forceinline__ void tile_step(WS& s, const ATT_LAS char* tile, const bf16x8 (&qr)[4], float fd0, float slope2, float Wf, ATT_LAS float* wsf, int lane) {
    const int r32 = lane & 31, hi = lane >> 5;
    f32x16 p0, p1;
#pragma unroll
    for (int r = 0; r < 16; ++r) { p0[r] = 0.f; p1[r] = 0.f; }
#pragma unroll
    for (int d0 = 0; d0 < 4; ++d0) {
        const int ch = 2 * d0 + hi; const ATT_LAS char* kc = tile + ch * 1024;
        const bf16x8 b0 = *(const ATT_LAS bf16x8*)(kc + ((r32 + ch) & 63) * 16), b1 = *(const ATT_LAS bf16x8*)(kc + ((r32 + 32 + ch) & 63) * 16);
        p0 = __builtin_amdgcn_mfma_f32_32x32x16_bf16(b0, qr[d0], p0, 0, 0, 0);
        p1 = __builtin_amdgcn_mfma_f32_32x32x16_bf16(b1, qr[d0], p1, 0, 0, 0);
    }
    float mx = NEGF;
#pragma unroll
    for (int r = 0; r < 16; ++r) {
        const float c = (float)((r & 3) + 8 * (r >> 2));
        const float a0 = __builtin_fabsf(fd0 + c), a1 = __builtin_fabsf(fd0 + (c + 32.f));
        const float x0 = __builtin_fmaf(-slope2, a0, p0[r]), x1 = __builtin_fmaf(-slope2, a1, p1[r]);
        p0[r] = (a0 <= Wf) ? x0 : NEGF; p1[r] = (a1 <= Wf) ? x1 : NEGF;
        mx = __builtin_fmaxf(mx, __builtin_fmaxf(p0[r], p1[r]));
    }
    mx = __builtin_fmaxf(mx, __shfl_xor(mx, 32));
    const float mn = __builtin_fmaxf(s.m, mx);
    const float f = __builtin_amdgcn_exp2f(s.m - mn);
    s.m = mn;
    float ls = 0.f;
#pragma unroll
    for (int r = 0; r < 16; ++r) { p0[r] = __builtin_amdgcn_exp2f(p0[r] - mn); p1[r] = __builtin_amdgcn_exp2f(p1[r] - mn); ls += p0[r] + p1[r]; }
    s.l = s.l * f + ls;
    if (__any(f != 1.0f)) {
        if (hi == 0) wsf[r32] = f;
#pragma unroll
        for (int i = 0; i < 4; ++i) { const f32x4 fv = *(const ATT_LAS f32x4*)(wsf + 8 * i + 4 * hi);
#pragma unroll
            for (int j = 0; j < 4; ++j) { s.o0[4 * i + j] *= fv[j]; s.o1[4 * i + j] *= fv[j]; } }
    }
    u32x4 pw[4];
#pragma unroll
    for (int j = 0; j < 4; ++j) { pw[0][j] = cvtpk(p0[2 * j], p0[2 * j + 1]); pw[1][j] = cvtpk(p0[8 + 2 * j], p0[9 + 2 * j]); pw[2][j] = cvtpk(p1[2 * j], p1[2 * j + 1]); pw[3][j] = cvtpk(p1[8 + 2 * j], p1[9 + 2 * j]); }
    const ATT_LAS char* vb = tile + 8192 + ((lane >> 4) & 1) * 32 + (lane & 3) * 8 + (4 * hi + ((lane & 15) >> 2)) * 64;
#pragma unroll
    for (int ks = 0; ks < 4; ++ks) {
        const s16x4 l0 = vtr(vb + ks * 1024), h0 = vtr(vb + ks * 1024 + 512), l1 = vtr(vb + 4096 + ks * 1024), h1 = vtr(vb + 4096 + ks * 1024 + 512);
        const bf16x8 v0 = (bf16x8){l0[0], l0[1], l0[2], l0[3], h0[0], h0[1], h0[2], h0[3]}, v1 = (bf16x8){l1[0], l1[1], l1[2], l1[3], h1[0], h1[1], h1[2], h1[3]};
        const bf16x8 pa = __builtin_bit_cast(bf16x8, pw[ks]);
        s.o0 = __builtin_amdgcn_mfma_f32_32x32x16_bf16(pa, v0, s.o0, 0, 0, 0);
        s.o1 = __builtin_amdgcn_mfma_f32_32x32x16_bf16(pa, v1, s.o1, 0, 0, 0);
    }
}

__device__ __forceinline__ void store_o(const WS& s, float inv, bf16_t* orow0, size_t rstride, ATT_LAS float* wsf, int lane) {
    const int r32 = lane & 31, hi = lane >> 5;
    if (hi == 0) wsf[r32] = inv;
#pragma unroll
    for (int i = 0; i < 4; ++i) { const f32x4 fv = *(const ATT_LAS f32x4*)(wsf + 8 * i + 4 * hi);
#pragma unroll
        for (int j = 0; j < 4; ++j) { const int r = 4 * i + j; bf16_t* p = orow0 + (size_t)crow(r, hi) * rstride + r32;
            p[0] = (bf16_t)(cvtpk(s.o0[r] * fv[j], 0.f) & 0xffffu); p[32] = (bf16_t)(cvtpk(s.o1[r] * fv[j], 0.f) & 0xffffu); } }
}

__device__ __forceinline__ void attn_a_item(int item, const bf16_t* qkv  , bf16_t* O  , const float* sink, ATT_LAS char* lds, const int tid) {
    const int lane = tid & 63, wave = __builtin_amdgcn_readfirstlane(tid >> 6), r32 = lane & 31, hi = lane >> 5;
    const int qb = item & 31, kvh = (item >> 5) & 3, b = item >> 7;
    const int q0 = qb * 64, tok0 = b * 2048;
    ATT_LAS float* wsf = (ATT_LAS float*)(lds + WSF_OFF) + wave * 64;
    {
        u32x4 kr[5], vr[5];
#pragma unroll
        for (int j = 0; j < 5; ++j) { const int ks = q0 - 128 + 64 * j;
            if (ks >= 0 && ks < 2048) { const bf16_t* src = qkv + (size_t)(tok0 + ks + (tid >> 3)) * 1536 + 1024 + kvh * 64 + (tid & 7) * 8; kr[j] = *(const u32x4*)src; vr[j] = *(const u32x4*)(src + 256); } }
#pragma unroll
        for (int j = 0; j < 5; ++j) { const int ks = q0 - 128 + 64 * j; if (ks >= 0 && ks < 2048) stage_write(lds + j * TILE_B, tid, kr[j], vr[j]); }
    }
    const int g = wave & 3, half = wave >> 2, hq = kvh * 4 + g, qpos = q0 + 32 * half + r32;
    bf16x8 qr[4];
#pragma unroll
    for (int d0 = 0; d0 < 4; ++d0) qr[d0] = *(const bf16x8*)(qkv + (size_t)(tok0 + qpos) * 1536 + hq * 64 + d0 * 16 + hi * 8);
    const float slope2 = __builtin_amdgcn_exp2f(-0.5f * (float)(hq + 1)) * LOG2E;
    __syncthreads();
    WS s;
#pragma unroll
    for (int r = 0; r < 16; ++r) { s.o0[r] = 0.f; s.o1[r] = 0.f; }
    s.m = NEGF; s.l = 0.f;
    for (int j = 0; j < 5; ++j) { const int ks = q0 - 128 + 64 * j;
        if (ks >= 0 && ks < 2048) tile_step(s, lds + j * TILE_B, qr, (float)(ks - qpos + 4 * hi), slope2, 128.f, wsf, lane); }
    const float lt = s.l + __shfl_xor(s.l, 32);
    const float inv = 1.0f / (lt + __builtin_amdgcn_exp2f(sink[hq] * LOG2E - s.m));
    store_o(s, inv, O + (size_t)(tok0 + q0 + 32 * half) * 1024 + hq * 64, 1024, wsf, lane);
    __syncthreads();
}

__device__ __forceinline__ void half_barrier(ATT_LAS unsigned* cnt, unsigned& gen) {
    __builtin_amdgcn_fence(__ATOMIC_RELEASE, "workgroup");
    if ((threadIdx.x & 63) == 0) __hip_atomic_fetch_add(cnt, 1u, __ATOMIC_RELAXED, __HIP_MEMORY_SCOPE_WORKGROUP);
    gen += 4u;
    while (__hip_atomic_load(cnt, __ATOMIC_RELAXED, __HIP_MEMORY_SCOPE_WORKGROUP) < gen) __builtin_amdgcn_s_sleep(1);
    __builtin_amdgcn_fence(__ATOMIC_ACQUIRE, "workgroup");
}
__device__ __forceinline__ void attn_b_half(int item, int gi, int dil, const bf16_t* qkv  , bf16_t* O  , float* lse  ,
                                            ATT_LAS char* ldsh, ATT_LAS float* wsf, const int t256, const int wq, const int lane, ATT_LAS unsigned* cnt, unsigned& gen, const bool wg_sync_after_stage) {
    const int r32 = lane & 31, hi = lane >> 5;
    const int h = item & 15, within = (item >> 4) & 15, b = item >> 8;
    const int res = within % dil, qb = within / dil, L = 2048 / dil, u0 = qb * 128, tokb = b * 2048 + res;
    {
        u32x4 kr[8], vr[8];
#pragma unroll
        for (int t = 0; t < 8; ++t) { const int j = t >> 1, pidx = t256 + 256 * (t & 1), ks = u0 - 64 + 64 * j;
            if (ks >= 0 && ks < L) { const bf16_t* src = qkv + (size_t)(tokb + (ks + (pidx >> 3)) * dil) * 3072 + 1024 + h * 64 + (pidx & 7) * 8; kr[t] = *(const u32x4*)src; vr[t] = *(const u32x4*)(src + 1024); } }
#pragma unroll
        for (int t = 0; t < 8; ++t) { const int j = t >> 1, pidx = t256 + 256 * (t & 1), ks = u0 - 64 + 64 * j; if (ks >= 0 && ks < L) stage_write(ldsh + j * TILE_B, pidx, kr[t], vr[t]); }
    }
    const int qpos = u0 + 32 * wq + r32;
    const size_t qtok = (size_t)(tokb + qpos * dil);
    bf16x8 qr[4];
#pragma unroll
    for (int d0 = 0; d0 < 4; ++d0) qr[d0] = *(const bf16x8*)(qkv + qtok * 3072 + h * 64 + d0 * 16 + hi * 8);
    const float slope2 = __builtin_amdgcn_exp2f(-0.5f * (float)(h + 1)) * LOG2E * (float)dil;
    bf16_t* orow0 = O + (size_t)(tokb + (u0 + 32 * wq) * dil) * 1024 + h * 64;
    const size_t rstride = (size_t)dil * 1024;
    WS s;
    if (gi == 0) {
#pragma unroll
        for (int r = 0; r < 16; ++r) { s.o0[r] = 0.f; s.o1[r] = 0.f; }
        s.m = NEGF; s.l = 0.f;
    } else {
        s.m = lse[qtok * 16 + h]; s.l = (hi == 0) ? 1.0f : 0.0f;
#pragma unroll
        for (int r = 0; r < 16; ++r) { const bf16_t* p = orow0 + (size_t)crow(r, hi) * rstride + r32; s.o0[r] = bf2f(p[0]); s.o1[r] = bf2f(p[32]); }
    }
    if (wg_sync_after_stage) __syncthreads();
    half_barrier(cnt, gen);
    for (int jj = 0; jj < 3; ++jj) { const int j = (wq >> 1) + jj, ks = u0 - 64 + 64 * j;
        if (ks >= 0 && ks < L) tile_step(s, ldsh + j * TILE_B, qr, (float)(ks - qpos + 4 * hi), slope2, 64.f, wsf, lane); }
    const float lt = s.l + __shfl_xor(s.l, 32);
    if (hi == 0) lse[qtok * 16 + h] = s.m + __builtin_log2f(lt);
    store_o(s, 1.0f / lt, orow0, rstride, wsf, lane);
    half_barrier(cnt, gen);
}
}

#ifndef MK_MULTI
#define MK_MULTI 0
#endif
#ifndef REP_PH
#define REP_PH -1
#endif
#define LAS __attribute__((address_space(3)))
typedef unsigned short bf16;
typedef unsigned v4u __attribute__((ext_vector_type(4)));
typedef float f32x4 __attribute__((ext_vector_type(4)));
constexpr int NWAVES = 8, T = 16 * 2048, D = 1024, FF = 2816, NPH = 16;
constexpr size_t MiB = 1u << 20;
constexpr size_t WS_SSQ = 0, WS_LSE = 2 * MiB;
constexpr size_t WS_WQKVA = 4 * MiB, WS_WOA = 7 * MiB, WS_WGU0 = 9 * MiB, WS_WD0 = 20 * MiB, WS_WQKVB = 26 * MiB, WS_WOB = 44 * MiB, WS_WGU1 = 46 * MiB, WS_WD1 = 57 * MiB;
constexpr size_t WS_CTL = 63 * MiB, CTL_BYTES = 16384;
constexpr int MISC_OFF = 133120;
constexpr size_t WS_XB = 64 * MiB, WS_O = 128 * MiB, WS_BIG = 192 * MiB, WS_END = 384 * MiB;
constexpr int LDS_BYTES = 147456;

__device__ __forceinline__ unsigned f2bf(float f) { unsigned u = __builtin_bit_cast(unsigned, f); return (u + 0x7fffu + ((u >> 16) & 1u)) >> 16; }
__device__ __forceinline__ unsigned pk2(float lo, float hi) { return f2bf(lo) | (f2bf(hi) << 16); }
__device__ __forceinline__ float wave_sum(float v) {
#pragma unroll
    for (int o = 1; o < 64; o <<= 1) v += __shfl_xor(v, o);
    return v;
}
#define XB_TMO      128
#define XB_XCNT(j)  (256  + 64 * (j))
#define XB_XSUB(j)  (1280 + 64 * (j))
#define XB_XGEN(j)  (2304 + 64 * (j))
#define XB_TOP      3328
#define XB_TOPGEN   3392
#define XCD_BAR_WORDS 3456
#define XB_SPIN_CAP (1u << 18)

__device__ __forceinline__ unsigned xb_ld(unsigned* p)              { return __hip_atomic_load(p, __ATOMIC_RELAXED, __HIP_MEMORY_SCOPE_AGENT); }
__device__ __forceinline__ unsigned xb_add(unsigned* p, unsigned v) { return __hip_atomic_fetch_add(p, v, __ATOMIC_RELAXED, __HIP_MEMORY_SCOPE_AGENT); }
__device__ __forceinline__ unsigned xb_xcc_id() { return (unsigned)__builtin_amdgcn_s_getreg((3 << 11) | 20) & 0xFu; }
#define XB_SPIN(cond, bar) do { unsigned _sp = 0; while (cond) { __builtin_amdgcn_s_sleep(1); \
    if ((++_sp & 255u) == 0u) { if (xb_ld(&(bar)[XB_TMO])) break; if (_sp > XB_SPIN_CAP) { atomicAdd(&(bar)[XB_TMO], 1u); break; } } } } while (0)

struct XcdBarrier {
    unsigned* bar; unsigned x;
    volatile LAS unsigned* st;
};

__device__ __forceinline__ XcdBarrier xcd_barrier_post(unsigned* bar, volatile LAS unsigned* st) {
    XcdBarrier b; b.bar = bar; b.x = xb_xcc_id(); b.st = st;
    if (threadIdx.x == 0) (void)xb_add(&bar[XB_XCNT(b.x)], 1u);
    return b;
}
__device__ __forceinline__ void xcd_barrier_complete(unsigned* bar, unsigned x, unsigned& nloc, unsigned& nx) {
    const unsigned G = gridDim.x * gridDim.y * gridDim.z;
    unsigned sum, cnt, mine, sp = 0u;
    for (;;) {
        sum = 0u; cnt = 0u; mine = 0u;
#pragma unroll
        for (unsigned j = 0; j < 16; ++j) { const unsigned c = xb_ld(&bar[XB_XCNT(j)]); sum += c; cnt += (c > 0u) ? 1u : 0u; mine = (j == x) ? c : mine; }
        if (sum == G) break;
        __builtin_amdgcn_s_sleep(1);
        if ((++sp & 255u) == 0u) { if (xb_ld(&bar[XB_TMO])) break; if (sp > XB_SPIN_CAP) { atomicAdd(&bar[XB_TMO], 1u); break; } }
    }
    nloc = mine > 0u ? mine : 1u; nx = cnt > 0u ? cnt : 1u;
}

__device__ __forceinline__ void xcd_barrier(const XcdBarrier& b) {
    asm volatile("s_waitcnt vmcnt(0)" ::: "memory");
    __syncthreads();
    if (threadIdx.x == 0) {
        unsigned* bar = b.bar;
        __builtin_amdgcn_s_waitcnt(0);
        unsigned nloc = b.st[0], nx = b.st[1];
        if (nloc == 0u) { xcd_barrier_complete(bar, b.x, nloc, nx); b.st[0] = nloc; b.st[1] = nx; }
        const unsigned old = xb_add(&bar[XB_XSUB(b.x)], 1u);
        const unsigned gen = old / nloc;
        if (old + 1u == (gen + 1u) * nloc) {
            __builtin_amdgcn_fence(__ATOMIC_RELEASE, "agent");
            asm volatile("s_waitcnt vmcnt(0)" ::: "memory");
            const unsigned og = xb_add(&bar[XB_TOP], 1u);
            const unsigned tg = og / nx;
            if (og + 1u == (tg + 1u) * nx) xb_add(&bar[XB_TOPGEN], 1u);
            else XB_SPIN(xb_ld(&bar[XB_TOPGEN]) == tg, bar);
            __builtin_amdgcn_fence(__ATOMIC_ACQUIRE, "agent");
            xb_add(&bar[XB_XGEN(b.x)], 1u);
            asm volatile("s_waitcnt vmcnt(0)" ::: "memory");
        } else {
            XB_SPIN(xb_ld(&bar[XB_XGEN(b.x)]) == gen, bar);
            __builtin_amdgcn_fence(__ATOMIC_ACQUIRE, "agent");
            asm volatile("s_waitcnt vmcnt(0)" ::: "memory");
        }
    }
    __syncthreads();
}

__device__ __forceinline__ void transpose_item(const float* W, int K, int N, bf16* WT, const float* gs, int mode, LAS float* scr, int item, int lane) {
    const int nblk = N / 32, kb = item / nblk, nb = item % nblk, k0 = 64 * kb, n0 = 32 * nb;
    float wv[32];
#pragma unroll
    for (int i = 0; i < 32; ++i) { const int kk = 2 * i + (lane >> 5); wv[i] = W[(size_t)(k0 + kk) * N + n0 + (lane & 31)]; }
    if (gs) {
#pragma unroll
        for (int i = 0; i < 32; ++i) wv[i] *= gs[k0 + 2 * i + (lane >> 5)];
    }
#pragma unroll
    for (int i = 0; i < 32; ++i) scr[(2 * i + (lane >> 5)) * 33 + (lane & 31)] = wv[i];
    asm volatile("s_waitcnt lgkmcnt(0)" ::: "memory");
    const int c = lane & 7;
    const int rbase = (mode == 0) ? n0 : (256 * (n0 >> 7) + (n0 & 127) + (mode == 2 ? 128 : 0));
#pragma unroll
    for (int j = 0; j < 4; ++j) { const int n = (lane >> 3) + 8 * j; const LAS float* s = scr + (8 * c) * 33 + n;
        v4u o; o.x = pk2(s[0 * 33], s[1 * 33]); o.y = pk2(s[2 * 33], s[3 * 33]); o.z = pk2(s[4 * 33], s[5 * 33]); o.w = pk2(s[6 * 33], s[7 * 33]);
        *(v4u*)(WT + (size_t)(rbase + n) * K + k0 + 8 * c) = o; }
    asm volatile("s_waitcnt lgkmcnt(0)" ::: "memory");
}

struct Args { const float* in[12]; float* out; unsigned char* ws; int ph_lo, ph_hi; };

__global__ void __launch_bounds__(NWAVES * 64, 2) fwd_megakernel(Args a) {
    extern __shared__ __attribute__((aligned(16))) unsigned char lds_raw[];
    LAS unsigned char* lds = (LAS unsigned char*)lds_raw;
    cg::grid_group grid = cg::this_grid();
    const int G = gridDim.x, bid = blockIdx.x;
    unsigned char* ws = a.ws;
    float* ssqp = (float*)(ws + WS_SSQ); float* lse = (float*)(ws + WS_LSE);
    bf16* XB = (bf16*)(ws + WS_XB); bf16* OB = (bf16*)(ws + WS_O); bf16* BIG = (bf16*)(ws + WS_BIG);
    const int NGW = G * NWAVES;
    if (threadIdx.x < 2) ((volatile LAS unsigned*)(lds + MISC_OFF))[threadIdx.x] = 0u;
    __syncthreads();
    XcdBarrier bar = xcd_barrier_post((unsigned*)(ws + WS_CTL), (volatile LAS unsigned*)(lds + MISC_OFF));

    bool rep_done = false;
    for (int ph = a.ph_lo; ph < a.ph_hi; ++ph) {
        int tid = threadIdx.x; asm volatile("" : "+v"(tid));
        const int lane = tid & 63, wave = __builtin_amdgcn_readfirstlane(tid >> 6), gw = bid * NWAVES + wave;
        if (ph == 0) {
            LAS float* scr = (LAS float*)(lds + wave * 16384);
            constexpr int I_QA = 16 * 48, I_O = 16 * 32, I_G = 16 * 88, I_D = 44 * 32, I_QB = 16 * 288;
            constexpr int NITEMS = I_QA + 2 * I_O + 4 * I_G + 2 * I_D + I_QB;
            for (int it = gw; it < NITEMS; it += NGW) {
                int r = it;
                if (r < I_QA) { transpose_item(a.in[3], D, 1536, (bf16*)(ws + WS_WQKVA), a.in[1], 0, scr, r, lane); continue; } r -= I_QA;
                if (r < I_O) { transpose_item(a.in[4], D, D, (bf16*)(ws + WS_WOA), nullptr, 0, scr, r, lane); continue; } r -= I_O;
                if (r < I_O) { transpose_item(a.in[7], D, D, (bf16*)(ws + WS_WOB), nullptr, 0, scr, r, lane); continue; } r -= I_O;
                if (r < I_G) { transpose_item(a.in[8], D, FF, (bf16*)(ws + WS_WGU0), a.in[2], 1, scr, r, lane); continue; } r -= I_G;
                if (r < I_G) { transpose_item(a.in[9], D, FF, (bf16*)(ws + WS_WGU0), a.in[2], 2, scr, r, lane); continue; } r -= I_G;
                if (r < I_G) { transpose_item(a.in[8] + (size_t)D * FF, D, FF, (bf16*)(ws + WS_WGU1), a.in[2] + D, 1, scr, r, lane); continue; } r -= I_G;
                if (r < I_G) { transpose_item(a.in[9] + (size_t)D * FF, D, FF, (bf16*)(ws + WS_WGU1), a.in[2] + D, 2, scr, r, lane); continue; } r -= I_G;
                if (r < I_D) { transpose_item(a.in[10], FF, D, (bf16*)(ws + WS_WD0), nullptr, 0, scr, r, lane); continue; } r -= I_D;
                if (r < I_D) { transpose_item(a.in[10] + (size_t)FF * D, FF, D, (bf16*)(ws + WS_WD1), nullptr, 0, scr, r, lane); continue; } r -= I_D;
                transpose_item(a.in[6], D, 9216, (bf16*)(ws + WS_WQKVB), a.in[1] + D, 0, scr, r, lane);
            }
            for (int m0 = gw * 4; m0 < T; m0 += NGW * 4) {
                f32x4 v[4][4];
#pragma unroll
                for (int q = 0; q < 4; ++q) { const f32x4* xr = (const f32x4*)(a.in[0] + (size_t)(m0 + q) * D) + lane;
#pragma unroll
                    for (int j = 0; j < 4; ++j) v[q][j] = xr[64 * j]; }
#pragma unroll
                for (int q = 0; q < 4; ++q) { float s = 0.f;
#pragma unroll
                    for (int j = 0; j < 4; ++j) s += (v[q][j].x * v[q][j].x + v[q][j].y * v[q][j].y) + (v[q][j].z * v[q][j].z + v[q][j].w * v[q][j].w);
                    s = wave_sum(s);
                    unsigned long long* o8 = (unsigned long long*)(XB + (size_t)(m0 + q) * D) + lane;
#pragma unroll
                    for (int j = 0; j < 4; ++j) o8[64 * j] = (unsigned long long)pk2(v[q][j].x, v[q][j].y) | ((unsigned long long)pk2(v[q][j].z, v[q][j].w) << 32);
                    if (lane < 16) ssqp[(size_t)(m0 + q) * 16 + lane] = (lane == 0) ? s : 0.f; }
            }
            __syncthreads();
        } else if (ph == 1 || ph == 6 || ph == 8 || ph == 10) {
            const int gi = (ph - 6) >> 1;
            const int N = (ph == 1) ? 1536 : 3072;
            const bf16* Bt = (ph == 1) ? (const bf16*)(ws + WS_WQKVA) : (const bf16*)(ws + WS_WQKVB) + (size_t)gi * 3072 * D;
            pg8::Gemm g{XB, Bt, T, N, D}; pg8::StaticOrder S; S.init(T, N, G, bid);
            pg8::EpiQKV E{BIG, N, ssqp, 4};
#ifndef DIS_QKV
            pg8::gemm_phase<pg8::EpiQKV, pg8::StaticOrder, true, true>(lds, g, S, E, tid);
#endif
        } else if (ph == 2) {
#ifndef DIS_ATTA
            for (int it = bid; it < 2048; it += G) att::attn_a_item(it, BIG, OB, a.in[5], (LAS char*)lds, tid);
#endif
        } else if (ph == 7 || ph == 9 || ph == 11) {
            const int gi = (ph - 7) >> 1, dil = (gi == 0) ? 1 : (gi == 1 ? 4 : 16);
            {
                const int hh = wave >> 2, halfid = bid * 2 + hh, nhalf = G * 2;
                att::ATT_LAS_U* cnt = (att::ATT_LAS_U*)(lds + MISC_OFF + 64) + hh * 16;
                if (tid < 32) ((att::ATT_LAS_U*)(lds + MISC_OFF + 64))[tid] = 0u;
                __syncthreads();
                unsigned gen = 0u;
                att::ATT_LAS_C* ldsh = (att::ATT_LAS_C*)lds + hh * 65536;
                att::ATT_LAS_F* wsf = (att::ATT_LAS_F*)(lds + att::WSF_OFF) + wave * 64;
                if (hh == 1) __syncthreads();
                bool first = (hh == 0);
                for (int it = halfid; it < 4096; it += nhalf) { att::attn_b_half(it, gi, dil, BIG, OB, lse, ldsh, wsf, tid & 255, wave & 3, lane, cnt, gen, first); first = false; }
            }
        } else if (ph == 3 || ph == 5 || ph == 12 || ph == 14) {
            const bool down = (ph == 5 || ph == 14);
            const bf16* A = down ? BIG : OB;
            const bf16* Bt = (const bf16*)(ws + (ph == 3 ? WS_WOA : ph == 5 ? WS_WD0 : ph == 12 ? WS_WOB : WS_WD1));
            pg8::Gemm g{A, Bt, T, D, down ? FF : D}; pg8::StaticOrder S; S.init(T, D, G, bid);
            pg8::EpiResid E{XB, ssqp};
#ifndef DIS_RES
            pg8::gemm_phase<pg8::EpiResid, pg8::StaticOrder, true, true>(lds, g, S, E, tid);
#endif
        } else if (ph == 4 || ph == 13) {
            const bf16* Bt = (const bf16*)(ws + (ph == 4 ? WS_WGU0 : WS_WGU1));
            pg8::Gemm g{XB, Bt, T, 2 * FF, D}; pg8::StaticOrder S; S.init(T, 2 * FF, G, bid);
            pg8::EpiSwiGLU E{BIG, ssqp};
#ifndef DIS_SWI
            pg8::gemm_phase<pg8::EpiSwiGLU, pg8::StaticOrder, true, true>(lds, g, S, E, tid);
#endif
        } else {
            const float* gf = a.in[11];
            for (int m = gw; m < T; m += NGW) {
                float s = (lane < 16) ? ssqp[(size_t)m * 16 + lane] : 0.f;
                s = wave_sum(s);
                const float r = rsqrtf(s * (1.0f / 1024.0f) + 1e-6f);
                const unsigned long long* xr = (const unsigned long long*)(XB + (size_t)m * D) + lane;
                f32x4* orow = (f32x4*)(a.out + (size_t)m * D) + lane;
#pragma unroll
                for (int j = 0; j < 4; ++j) { const f32x4 gv = ((const f32x4*)gf)[lane + 64 * j]; const unsigned long long w = xr[64 * j]; const unsigned lo = (unsigned)w, hi = (unsigned)(w >> 32);
                    f32x4 v; v.x = __builtin_bit_cast(float, lo << 16); v.y = __builtin_bit_cast(float, lo & 0xffff0000u); v.z = __builtin_bit_cast(float, hi << 16); v.w = __builtin_bit_cast(float, hi & 0xffff0000u);
                    orow[64 * j] = v * r * gv; }
            }
        }
        if (ph + 1 < a.ph_hi) {
            if (a.ph_hi > NPH) { __threadfence(); grid.sync(); __builtin_amdgcn_fence(__ATOMIC_ACQUIRE, "agent"); }
            else xcd_barrier(bar);
        }
        if (REP_PH >= 0 && ph == REP_PH && !rep_done) { rep_done = true; --ph; }
    }
}

extern "C" void kernel_launch(void* const* d_in, const int* in_sizes, int n_in, void* d_out, int out_size, void* d_ws, size_t ws_size, hipStream_t stream) {
    static int grid = 0;
    if (grid == 0) {
        int dev = 0, cus = 0, per_cu = 0;
        if (n_in != 12 || out_size != T * D || ws_size < WS_END) { fprintf(stderr, "kernel_launch: unexpected shapes (n_in %d out %d ws %zu)\n", n_in, out_size, ws_size); grid = -1; return; }
        hipGetDevice(&dev);
        hipDeviceGetAttribute(&cus, hipDeviceAttributeMultiprocessorCount, dev);
        if (hipFuncSetAttribute((const void*)fwd_megakernel, hipFuncAttributeMaxDynamicSharedMemorySize, LDS_BYTES) != hipSuccess) { fprintf(stderr, "kernel_launch: hipFuncSetAttribute failed\n"); grid = -1; return; }
        if (hipOccupancyMaxActiveBlocksPerMultiprocessor(&per_cu, (const void*)fwd_megakernel, NWAVES * 64, LDS_BYTES) != hipSuccess || per_cu < 1) { fprintf(stderr, "kernel_launch: occupancy query says %d\n", per_cu); per_cu = 1; }
        (void)hipGetLastError();
        grid = cus;
        fprintf(stderr, "kernel_launch: grid %d (per_cu %d)\n", grid, per_cu);
    }
    if (grid < 0) return;
    if (hipMemsetAsync((char*)d_ws + WS_CTL, 0, CTL_BYTES, stream) != hipSuccess) { fprintf(stderr, "kernel_launch: memset failed\n"); return; }
    Args a{};
    for (int i = 0; i < 12; ++i) a.in[i] = (const float*)d_in[i];
    a.out = (float*)d_out; a.ws = (unsigned char*)d_ws;
#if MK_MULTI
    for (int ph = 0; ph < NPH; ++ph) {
        a.ph_lo = ph; a.ph_hi = ph + 1;
        void* args[] = {&a};
        hipError_t e = hipLaunchCooperativeKernel((const void*)fwd_megakernel, dim3(grid), dim3(NWAVES * 64), args, LDS_BYTES, stream);
        if (e != hipSuccess) { fprintf(stderr, "launch %d failed: %s\n", ph, hipGetErrorString(e)); break; }
    }
#else
    a.ph_lo = 0; a.ph_hi = NPH;
    void* args[] = {&a};
    hipError_t e = hipLaunchCooperativeKernel((const void*)fwd_megakernel, dim3(grid), dim3(NWAVES * 64), args, LDS_BYTES, stream);
    if (e != hipSuccess) fprintf(stderr, "cooperative launch failed: %s (grid %d)\n", hipGetErrorString(e), grid);
#endif
}
```

```cpp
#include <hip/hip_runtime.h>
#include <hip/hip_cooperative_groups.h>
#include <cstdio>
#include <cstdint>
namespace cg = cooperative_groups;
namespace pg8 {
#define PG8_LAS __attribute__((address_space(3)))
typedef unsigned short bf16_t;
typedef short bf16x8 __attribute__((ext_vector_type(8)));
typedef float f32x4 __attribute__((ext_vector_type(4)));
typedef unsigned u32x4 __attribute__((ext_vector_type(4)));
constexpr int BM = 256, BK = 64, HALF = 128, HTB = HALF * BK * 2  , STAGE_BYTES = 8 * HTB, NXCD = 8, WGM = 8;

__host__ __device__ __forceinline__ int lds_byte(int r, int c) { const int st = (r >> 4) * 2 + (c >> 5), rr = r & 15, cc = c & 31, ob = rr * 64 + cc * 2; return st * 1024 + (ob ^ (((ob >> 9) & 1) << 5)); }
__host__ __device__ __forceinline__ void stage_rc(int b, int& R, int& C) { const int st = b / 1024, sb = b % 1024, swz = sb ^ (((sb >> 9) & 1) << 5); R = (st >> 1) * 16 + swz / 64; C = (st & 1) * 32 + (swz % 64) / 2; }
__host__ __device__ __forceinline__ int perm32(int rho) { const int n = rho >> 4, i = rho & 15; return 8 * (i >> 2) + 4 * n + (i & 3); }

struct Unit { int pm, pn; };
struct Gemm { const bf16_t* A; const bf16_t* Bt; int M, N, K; };

struct StaticOrder {
    int nM, nN, nwg, G, c;
    __host__ __device__ void init(int M, int N, int G_, int c_) { nM = M / BM; nN = N / BM; nwg = nM * nN; G = G_; c = c_; }
    __host__ __device__ bool next(int i, Unit& u) const {
        const long L = (long)i * G + c; if (L >= nwg) return false;
        int wgid = (int)L; { const int q = nwg / NXCD, r = nwg % NXCD, xcd = wgid % NXCD, off = wgid / NXCD; wgid = (xcd < r ? xcd * (q + 1) : r * (q + 1) + (xcd - r) * q) + off; }
        const int nig = WGM * nN, gid = wgid / nig, fm = gid * WGM, gsz = (nM - fm) < WGM ? (nM - fm) : WGM;
        u.pm = fm + ((wgid % nig) % gsz); u.pn = (wgid % nig) / gsz; return true;
    }
    __device__ __forceinline__ void a_ready(const Unit&) const {}
    __device__ __forceinline__ void done(const Unit&) const {}
};

__device__ __forceinline__ unsigned cvt_pk_bf16(float lo, float hi) { unsigned r; asm volatile("v_cvt_pk_bf16_f32 %0, %1, %2" : "=v"(r) : "v"(lo), "v"(hi)); return r; }
constexpr float RMS_EPS_F = 1e-6f;
constexpr float QK_C2 = 0.125f * 1.4426950408889634f;
__device__ __forceinline__ float row_rscale(const float* ssqp, int row, int fq) {
    const f32x4 p = *(const f32x4*)(ssqp + (size_t)row * 16 + 4 * fq);
    float s = (p[0] + p[1]) + (p[2] + p[3]);
    s += __shfl_xor(s, 16); s += __shfl_xor(s, 32);
    return rsqrtf(s * (1.0f / 1024.0f) + RMS_EPS_F);
}
struct EpiQKV {
    static constexpr bool PERM = true, AFTER_DRAIN = false;
    bf16_t* O; int ldc; const float* ssqp; int qtiles;
    __device__ __forceinline__ void operator()(const f32x4 (&acc)[2][2][4][2], const Unit& u, int wr, int wc, int fr, int fq) const {
        const int row0 = u.pm * BM + wr * 64 + fr, col0 = u.pn * BM + wc * 32 + 8 * fq;
        const float sc = (u.pn < qtiles) ? QK_C2 : 1.0f;
#pragma unroll
        for (int ai = 0; ai < 2; ++ai)
#pragma unroll
            for (int m = 0; m < 4; ++m) { const int row = row0 + ai * HALF + m * 16; const float r = row_rscale(ssqp, row, fq) * sc;
                bf16_t* rowp = O + (size_t)row * ldc + col0;
#pragma unroll
                for (int bj = 0; bj < 2; ++bj) { const f32x4 v0 = acc[ai][bj][m][0] * r, v1 = acc[ai][bj][m][1] * r;
                    u32x4 w; w.x = cvt_pk_bf16(v0[0], v0[1]); w.y = cvt_pk_bf16(v0[2], v0[3]); w.z = cvt_pk_bf16(v1[0], v1[1]); w.w = cvt_pk_bf16(v1[2], v1[3]);
                    __builtin_nontemporal_store(w, (u32x4*)(rowp + bj * HALF)); } }
    }
};
struct EpiResid {
    static constexpr bool PERM = true, AFTER_DRAIN = false;
    bf16_t* xb; float* ssqp_out;
    __device__ __forceinline__ void operator()(const f32x4 (&acc)[2][2][4][2], const Unit& u, int wr, int wc, int fr, int fq) const {
        const int row0 = u.pm * BM + wr * 64 + fr, col0 = u.pn * BM + wc * 32 + 8 * fq;
#pragma unroll
        for (int ai = 0; ai < 2; ++ai)
#pragma unroll
            for (int m = 0; m < 4; ++m) { const int row = row0 + ai * HALF + m * 16; const size_t off = (size_t)row * 1024 + col0; float ss = 0.f;
#pragma unroll
                for (int bj = 0; bj < 2; ++bj) {
                    const u32x4 b = *(const u32x4*)(xb + off + bj * HALF);
                    f32x4 v0 = acc[ai][bj][m][0], v1 = acc[ai][bj][m][1];
                    v0[0] += __builtin_bit_cast(float, b.x << 16); v0[1] += __builtin_bit_cast(float, b.x & 0xffff0000u); v0[2] += __builtin_bit_cast(float, b.y << 16); v0[3] += __builtin_bit_cast(float, b.y & 0xffff0000u);
                    v1[0] += __builtin_bit_cast(float, b.z << 16); v1[1] += __builtin_bit_cast(float, b.z & 0xffff0000u); v1[2] += __builtin_bit_cast(float, b.w << 16); v1[3] += __builtin_bit_cast(float, b.w & 0xffff0000u);
                    u32x4 w; w.x = cvt_pk_bf16(v0[0], v0[1]); w.y = cvt_pk_bf16(v0[2], v0[3]); w.z = cvt_pk_bf16(v1[0], v1[1]); w.w = cvt_pk_bf16(v1[2], v1[3]);
                    *(u32x4*)(xb + off + bj * HALF) = w;
                    ss += (v0[0] * v0[0] + v0[1] * v0[1]) + (v0[2] * v0[2] + v0[3] * v0[3]) + (v1[0] * v1[0] + v1[1] * v1[1]) + (v1[2] * v1[2] + v1[3] * v1[3]); }
                ss += __shfl_xor(ss, 16); ss += __shfl_xor(ss, 32);
                if (fq == 0) ssqp_out[(size_t)row * 16 + u.pn * 4 + wc] = ss; }
    }
};
struct EpiSwiGLU {
    static constexpr bool PERM = true, AFTER_DRAIN = false;
    bf16_t* H; const float* ssqp;
    __device__ __forceinline__ void operator()(const f32x4 (&acc)[2][2][4][2], const Unit& u, int wr, int wc, int fr, int fq) const {
        const int row0 = u.pm * BM + wr * 64 + fr, hcol = u.pn * HALF + wc * 32 + 8 * fq;
#pragma unroll
        for (int ai = 0; ai < 2; ++ai)
#pragma unroll
            for (int m = 0; m < 4; ++m) { const int row = row0 + ai * HALF + m * 16; const float r = row_rscale(ssqp, row, fq);
                float hv[8];
#pragma unroll
                for (int n = 0; n < 2; ++n)
#pragma unroll
                    for (int j = 0; j < 4; ++j) { const float g = acc[ai][0][m][n][j] * r, up = acc[ai][1][m][n][j] * r;
                        const float sg = g * __builtin_amdgcn_rcpf(1.0f + __builtin_amdgcn_exp2f(-1.4426950408889634f * g)); hv[n * 4 + j] = sg * up; }
                u32x4 w; w.x = cvt_pk_bf16(hv[0], hv[1]); w.y = cvt_pk_bf16(hv[2], hv[3]); w.z = cvt_pk_bf16(hv[4], hv[5]); w.w = cvt_pk_bf16(hv[6], hv[7]);
                __builtin_nontemporal_store(w, (u32x4*)(H + (size_t)row * 2816 + hcol)); }
    }
};

template <class Epi, class Sched, bool ALIGN_EPI = false, bool SP2 = false>
__device__ __forceinline__ void gemm_phase(PG8_LAS unsigned char* lds, const Gemm g, const Sched& S, const Epi& E, const int tid) {
    const int wid = __builtin_amdgcn_readfirstlane(tid >> 6), lane = tid & 63, wr = wid >> 2, wc = wid & 3, fr = lane & 15, fq = lane >> 4;
    const int K = g.K, nt = K / BK;
    unsigned voffA[2], voffB[2];
#pragma unroll
    for (int i = 0; i < 2; ++i) { int R, C; stage_rc(tid * 16 + i * 8192, R, C); const int Rb = Epi::PERM ? ((R & ~31) + perm32(R & 31)) : R;
        voffA[i] = (unsigned)(R * K + C) * 2u; voffB[i] = (unsigned)(Rb * K + C) * 2u; }
    const size_t kstep = (size_t)(BK * 2);
    const size_t hstep = (size_t)HALF * K * 2;
    const size_t tstep = 2 * hstep;
    const unsigned ldsw = (unsigned)wid * 1024u;
    const int aoff = lds_byte(wr * 64 + fr, fq * 8), boff = lds_byte(wc * 32 + fr, fq * 8);
#define PG8_SA(b, h) (((b) * 2 + (h)) * HTB)
#define PG8_SB(b, h) ((4 + (b) * 2 + (h)) * HTB)
#define PG8_STAGE(bufoff, gbase, voff) do { _Pragma("unroll") for (int _i = 0; _i < 2; ++_i) \
        __builtin_amdgcn_global_load_lds((const unsigned*)((const char*)(gbase) + (voff)[_i]), (PG8_LAS unsigned*)(lds + (bufoff) + ldsw + _i * 8192), 16, 0, 0); } while (0)
#define PG8_LDA(dst, b, h) do { _Pragma("unroll") for (int m = 0; m < 4; ++m) _Pragma("unroll") for (int k = 0; k < 2; ++k) dst[m][k] = *(const PG8_LAS bf16x8*)(lds + PG8_SA(b, h) + aoff + m * 2048 + k * 1024); } while (0)
#define PG8_LDB(dst, b, h) do { _Pragma("unroll") for (int n = 0; n < 2; ++n) _Pragma("unroll") for (int k = 0; k < 2; ++k) dst[n][k] = *(const PG8_LAS bf16x8*)(lds + PG8_SB(b, h) + boff + n * 2048 + k * 1024); } while (0)
#define PG8_MMA(ai, bj, At, Bt) do { __builtin_amdgcn_s_setprio(1); _Pragma("unroll") for (int m = 0; m < 4; ++m) _Pragma("unroll") for (int n = 0; n < 2; ++n) _Pragma("unroll") for (int k = 0; k < 2; ++k) \
        acc[ai][bj][m][n] = __builtin_amdgcn_mfma_f32_16x16x32_bf16(Bt[n][k], At[m][k], acc[ai][bj][m][n], 0, 0, 0); __builtin_amdgcn_s_setprio(0); } while (0)
#define PG8_WAIT_V(n) asm volatile("s_waitcnt vmcnt(" #n ")" ::: "memory")
#define PG8_WAIT_L(n) asm volatile("s_waitcnt lgkmcnt(" #n ")" ::: "memory")
#define PG8_BAR __builtin_amdgcn_s_barrier()
#define PG8_SCHED __builtin_amdgcn_sched_barrier(0)
    Unit cur, nxt; int ui = 0;
    if (!S.next(0, cur)) return;
    f32x4 acc[2][2][4][2];
#pragma unroll
    for (int a = 0; a < 2; ++a)
#pragma unroll
        for (int b = 0; b < 2; ++b)
#pragma unroll
            for (int m = 0; m < 4; ++m)
#pragma unroll
                for (int n = 0; n < 2; ++n) acc[a][b][m][n] = (f32x4){0.f, 0.f, 0.f, 0.f};
    bf16x8 At[4][2], B0[2][2], B1[2][2];
    const char* cA = (const char*)g.A + (size_t)cur.pm * tstep; const char* cB = (const char*)g.Bt + (size_t)cur.pn * tstep;
    S.a_ready(cur);
    if constexpr (SP2) {
        PG8_STAGE(PG8_SB(0, 0), cB, voffB); PG8_STAGE(PG8_SB(0, 1), cB + hstep, voffB); PG8_STAGE(PG8_SA(0, 0), cA, voffA); PG8_STAGE(PG8_SA(0, 1), cA + hstep, voffA);
        if (wr == 1) PG8_BAR;
        PG8_WAIT_V(2); PG8_BAR;
        PG8_STAGE(PG8_SB(1, 0), cB + kstep, voffB); PG8_STAGE(PG8_SA(1, 0), cA + kstep, voffA); PG8_STAGE(PG8_SB(1, 1), cB + hstep + kstep, voffB);
        PG8_WAIT_V(6); PG8_BAR;
    } else {
        PG8_STAGE(PG8_SB(0, 0), cB, voffB); PG8_STAGE(PG8_SA(0, 0), cA, voffA); PG8_STAGE(PG8_SB(0, 1), cB + hstep, voffB); PG8_STAGE(PG8_SA(0, 1), cA + hstep, voffA);
        if (wr == 1) PG8_BAR;
        PG8_WAIT_V(4); PG8_BAR;
        PG8_STAGE(PG8_SB(1, 0), cB + kstep, voffB); PG8_STAGE(PG8_SA(1, 0), cA + kstep, voffA); PG8_STAGE(PG8_SB(1, 1), cB + hstep + kstep, voffB);
        PG8_WAIT_V(6); PG8_BAR;
    }
    for (;;) {
        const bool has_next = S.next(ui + 1, nxt);
        const char* nA = has_next ? (const char*)g.A + (size_t)nxt.pm * tstep : cA; const char* nB = has_next ? (const char*)g.Bt + (size_t)nxt.pn * tstep : cB;
        for (int t = 0; t < nt; t += 2) {
            const bool last = (t == nt - 2);
            const char* a1 = cA + (size_t)(t + 1) * kstep;
            const char* a2 = last ? nA : cA + (size_t)(t + 2) * kstep; const char* b2 = last ? nB : cB + (size_t)(t + 2) * kstep;
            const char* a3 = a2 + kstep; const char* b3 = b2 + kstep;
            if (last && has_next) S.a_ready(nxt);
            if constexpr (SP2) {
            PG8_LDB(B0, 0, 0); PG8_LDB(B1, 0, 1); PG8_SCHED; PG8_LDA(At, 0, 0); PG8_STAGE(PG8_SA(1, 1), a1 + hstep, voffA);
            PG8_WAIT_V(8); PG8_WAIT_L(0); PG8_BAR; PG8_MMA(0, 0, At, B0); PG8_MMA(0, 1, At, B1); PG8_BAR; PG8_SCHED;
            PG8_LDA(At, 0, 1); PG8_STAGE(PG8_SB(0, 0), b2, voffB); PG8_STAGE(PG8_SB(0, 1), b2 + hstep, voffB); PG8_STAGE(PG8_SA(0, 0), a2, voffA);
            PG8_WAIT_V(8); PG8_WAIT_L(0); PG8_BAR; PG8_MMA(1, 0, At, B0); PG8_MMA(1, 1, At, B1); PG8_BAR; PG8_SCHED;
            PG8_LDB(B0, 1, 0); PG8_LDB(B1, 1, 1); PG8_SCHED; PG8_LDA(At, 1, 0); PG8_STAGE(PG8_SA(0, 1), a2 + hstep, voffA);
            PG8_WAIT_V(8); PG8_WAIT_L(0); PG8_BAR; PG8_MMA(0, 0, At, B0); PG8_MMA(0, 1, At, B1); PG8_BAR; PG8_SCHED;
            PG8_LDA(At, 1, 1); PG8_STAGE(PG8_SB(1, 0), b3, voffB); PG8_STAGE(PG8_SB(1, 1), b3 + hstep, voffB); PG8_STAGE(PG8_SA(1, 0), a3, voffA);
            PG8_WAIT_V(8); PG8_WAIT_L(0); PG8_BAR; PG8_MMA(1, 0, At, B0); PG8_MMA(1, 1, At, B1); PG8_BAR; PG8_SCHED;
            } else {
            PG8_LDB(B0, 0, 0); PG8_SCHED; PG8_LDA(At, 0, 0); PG8_STAGE(PG8_SA(1, 1), a1 + hstep, voffA);
            PG8_WAIT_L(8); PG8_BAR; PG8_WAIT_L(0); PG8_MMA(0, 0, At, B0); PG8_BAR; PG8_SCHED;
            PG8_LDB(B1, 0, 1); PG8_STAGE(PG8_SB(0, 0), b2, voffB);
            PG8_BAR; PG8_WAIT_L(0); PG8_MMA(0, 1, At, B1); PG8_BAR;
            PG8_LDA(At, 0, 1); PG8_STAGE(PG8_SA(0, 0), a2, voffA);
            PG8_BAR; PG8_WAIT_L(0); PG8_MMA(1, 0, At, B0); PG8_BAR; PG8_SCHED;
            PG8_STAGE(PG8_SB(0, 1), b2 + hstep, voffB);
            PG8_WAIT_V(6); PG8_BAR; PG8_MMA(1, 1, At, B1); PG8_BAR;
            PG8_LDB(B0, 1, 0); PG8_SCHED; PG8_LDA(At, 1, 0); PG8_STAGE(PG8_SA(0, 1), a2 + hstep, voffA);
            PG8_WAIT_L(8); PG8_BAR; PG8_WAIT_L(0); PG8_MMA(0, 0, At, B0); PG8_BAR; PG8_SCHED;
            PG8_LDB(B1, 1, 1); PG8_STAGE(PG8_SB(1, 0), b3, voffB);
            PG8_BAR; PG8_WAIT_L(0); PG8_MMA(0, 1, At, B1); PG8_BAR;
            PG8_LDA(At, 1, 1); PG8_STAGE(PG8_SA(1, 0), a3, voffA);
            PG8_BAR; PG8_WAIT_L(0); PG8_MMA(1, 0, At, B0); PG8_BAR; PG8_SCHED;
            PG8_STAGE(PG8_SB(1, 1), b3 + hstep, voffB);
            PG8_WAIT_V(6); PG8_BAR; PG8_MMA(1, 1, At, B1); PG8_BAR;
            }
        }
        if constexpr (ALIGN_EPI) { if (wr == 0) PG8_BAR; }
        if constexpr (!Epi::AFTER_DRAIN) { E(acc, cur, wr, wc, fr, fq); S.done(cur); }
        if (!has_next) break;
#pragma unroll
        for (int a = 0; a < 2; ++a)
#pragma unroll
            for (int b = 0; b < 2; ++b)
#pragma unroll
                for (int m = 0; m < 4; ++m)
#pragma unroll
                    for (int n = 0; n < 2; ++n) acc[a][b][m][n] = (f32x4){0.f, 0.f, 0.f, 0.f};
        cur = nxt; cA = nA; cB = nB; ++ui;
        if constexpr (ALIGN_EPI) { if (wr == 1) PG8_BAR; }
    }
    PG8_WAIT_V(0);
    if constexpr (!ALIGN_EPI) { if (wr == 0) PG8_BAR; }
    PG8_BAR;
    if constexpr (Epi::AFTER_DRAIN) { E.fused(acc, cur, wr, wc, fr, fq, lds, wid, lane); S.done(cur); }
#undef PG8_SA
#undef PG8_SB
#undef PG8_STAGE
#undef PG8_LDA
#undef PG8_LDB
#undef PG8_MMA
#undef PG8_WAIT_V
#undef PG8_WAIT_L
#undef PG8_BAR
#undef PG8_SCHED
}
}
namespace att {
#define ATT_LAS __attribute__((address_space(3)))
typedef unsigned short bf16_t;
typedef short bf16x8 __attribute__((ext_vector_type(8)));
typedef short s16x4 __attribute__((ext_vector_type(4)));
typedef short v4i16_t __attribute__((ext_vector_type(4)));
typedef float f32x16 __attribute__((ext_vector_type(16)));
typedef float f32x4 __attribute__((ext_vector_type(4)));
typedef unsigned u32x4 __attribute__((ext_vector_type(4)));
typedef float f32x2_t __attribute__((ext_vector_type(2)));
typedef __bf16 bf16x2_t __attribute__((ext_vector_type(2)));
typedef ATT_LAS unsigned ATT_LAS_U; typedef ATT_LAS char ATT_LAS_C; typedef ATT_LAS float ATT_LAS_F;
constexpr float NEGF = -1e30f, LOG2E = 1.4426950408889634f;
constexpr int TILE_B = 16384;
constexpr int WSF_OFF = 131072;

__device__ __forceinline__ int crow(int r, int hi) { return (r & 3) + 8 * (r >> 2) + 4 * hi; }
__device__ __forceinline__ unsigned cvtpk(float lo, float hi) { f32x2_t v = {lo, hi}; bf16x2_t b = __builtin_convertvector(v, bf16x2_t); return __builtin_bit_cast(unsigned, b); }
__device__ __forceinline__ s16x4 vtr(const ATT_LAS char* p) { return __builtin_bit_cast(s16x4, __builtin_amdgcn_ds_read_tr16_b64_v4i16((ATT_LAS v4i16_t*)p)); }
__device__ __forceinline__ float bf2f(unsigned short b) { return __builtin_bit_cast(float, (unsigned)b << 16); }

__device__ __forceinline__ void stage_write(ATT_LAS char* tile, int idx, u32x4 kv, u32x4 vv) {
    const int key = idx >> 3, ch = idx & 7;
    *(ATT_LAS u32x4*)(tile + ch * 1024 + ((key + ch) & 63) * 16) = kv;
    *(ATT_LAS u32x4*)(tile + 8192 + (ch >> 2) * 4096 + (key >> 4) * 1024 + (key & 15) * 64 + (ch & 3) * 16) = vv;
}

struct WS { f32x16 o0, o1; float m, l; };

__device__ __forceinline__ void tile_step(WS& s, const ATT_LAS char* tile, const bf16x8 (&qr)[4], float fd0, float slope2, float Wf, ATT_LAS float* wsf, int lane) {
    const int r32 = lane & 31, hi = lane >> 5;
    f32x16 p0, p1;
#pragma unroll
    for (int r = 0; r < 16; ++r) { p0[r] = 0.f; p1[r] = 0.f; }
#pragma unroll
    for (int d0 = 0; d0 < 4; ++d0) {
        const int ch = 2 * d0 + hi; const ATT_LAS char* kc = tile + ch * 1024;
        const bf16x8 b0 = *(const ATT_LAS bf16x8*)(kc + ((r32 + ch) & 63) * 16), b1 = *(const ATT_LAS bf16x8*)(kc + ((r32 + 32 + ch) & 63) * 16);
        p0 = __builtin_amdgcn_mfma_f32_32x32x16_bf16(b0, qr[d0], p0, 0, 0, 0);
        p1 = __builtin_amdgcn_mfma_f32_32x32x16_bf16(b1, qr[d0], p1, 0, 0, 0);
    }
    float mx = NEGF;
#pragma unroll
    for (int r = 0; r < 16; ++r) {
        const float c = (float)((r & 3) + 8 * (r >> 2));
        const float a0 = __builtin_fabsf(fd0 + c), a1 = __builtin_fabsf(fd0 + (c + 32.f));
        const float x0 = __builtin_fmaf(-slope2, a0, p0[r]), x1 = __builtin_fmaf(-slope2, a1, p1[r]);
        p0[r] = (a0 <= Wf) ? x0 : NEGF; p1[r] = (a1 <= Wf) ? x1 : NEGF;
        mx = __builtin_fmaxf(mx, __builtin_fmaxf(p0[r], p1[r]));
    }
    mx = __builtin_fmaxf(mx, __shfl_xor(mx, 32));
    const float mn = __builtin_fmaxf(s.m, mx);
    const float f = __builtin_amdgcn_exp2f(s.m - mn);
    s.m = mn;
    float ls = 0.f;
#pragma unroll
    for (int r = 0; r < 16; ++r) { p0[r] = __builtin_amdgcn_exp2f(p0[r] - mn); p1[r] = __builtin_amdgcn_exp2f(p1[r] - mn); ls += p0[r] + p1[r]; }
    s.l = s.l * f + ls;
    if (__any(f != 1.0f)) {
        if (hi == 0) wsf[r32] = f;
#pragma unroll
        for (int i = 0; i < 4; ++i) { const f32x4 fv = *(const ATT_LAS f32x4*)(wsf + 8 * i + 4 * hi);
#pragma unroll
            for (int j = 0; j < 4; ++j) { s.o0[4 * i + j] *= fv[j]; s.o1[4 * i + j] *= fv[j]; } }
    }
    u32x4 pw[4];
#pragma unroll
    for (int j = 0; j < 4; ++j) { pw[0][j] = cvtpk(p0[2 * j], p0[2 * j + 1]); pw[1][j] = cvtpk(p0[8 + 2 * j], p0[9 + 2 * j]); pw[2][j] = cvtpk(p1[2 * j], p1[2 * j + 1]); pw[3][j] = cvtpk(p1[8 + 2 * j], p1[9 + 2 * j]); }
    const ATT_LAS char* vb = tile + 8192 + ((lane >> 4) & 1) * 32 + (lane & 3) * 8 + (4 * hi + ((lane & 15) >> 2)) * 64;
#pragma unroll
    for (int ks = 0; ks < 4; ++ks) {
        const s16x4 l0 = vtr(vb + ks * 1024), h0 = vtr(vb + ks * 1024 + 512), l1 = vtr(vb + 4096 + ks * 1024), h1 = vtr(vb + 4096 + ks * 1024 + 512);
        const bf16x8 v0 = (bf16x8){l0[0], l0[1], l0[2], l0[3], h0[0], h0[1], h0[2], h0[3]}, v1 = (bf16x8){l1[0], l1[1], l1[2], l1[3], h1[0], h1[1], h1[2], h1[3]};
        const bf16x8 pa = __builtin_bit_cast(bf16x8, pw[ks]);
        s.o0 = __builtin_amdgcn_mfma_f32_32x32x16_bf16(pa, v0, s.o0, 0, 0, 0);
        s.o1 = __builtin_amdgcn_mfma_f32_32x32x16_bf16(pa, v1, s.o1, 0, 0, 0);
    }
}

__device__ __forceinline__ void store_o(const WS& s, float inv, bf16_t* orow0, size_t rstride, ATT_LAS float* wsf, int lane) {
    const int r32 = lane & 31, hi = lane >> 5;
    if (hi == 0) wsf[r32] = inv;
#pragma unroll
    for (int i = 0; i < 4; ++i) { const f32x4 fv = *(const ATT_LAS f32x4*)(wsf + 8 * i + 4 * hi);
#pragma unroll
        for (int j = 0; j < 4; ++j) { const int r = 4 * i + j; bf16_t* p = orow0 + (size_t)crow(r, hi) * rstride + r32;
            p[0] = (bf16_t)(cvtpk(s.o0[r] * fv[j], 0.f) & 0xffffu); p[32] = (bf16_t)(cvtpk(s.o1[r] * fv[j], 0.f) & 0xffffu); } }
}

__device__ __forceinline__ void attn_a_item(int item, const bf16_t* qkv  , bf16_t* O  , const float* sink, ATT_LAS char* lds, const int tid) {
    const int lane = tid & 63, wave = __builtin_amdgcn_readfirstlane(tid >> 6), r32 = lane & 31, hi = lane >> 5;
    const int qb = item & 31, kvh = (item >> 5) & 3, b = item >> 7;
    const int q0 = qb * 64, tok0 = b * 2048;
    ATT_LAS float* wsf = (ATT_LAS float*)(lds + WSF_OFF) + wave * 64;
    {
        u32x4 kr[5], vr[5];
#pragma unroll
        for (int j = 0; j < 5; ++j) { const int ks = q0 - 128 + 64 * j;
            if (ks >= 0 && ks < 2048) { const bf16_t* src = qkv + (size_t)(tok0 + ks + (tid >> 3)) * 1536 + 1024 + kvh * 64 + (tid & 7) * 8; kr[j] = *(const u32x4*)src; vr[j] = *(const u32x4*)(src + 256); } }
#pragma unroll
        for (int j = 0; j < 5; ++j) { const int ks = q0 - 128 + 64 * j; if (ks >= 0 && ks < 2048) stage_write(lds + j * TILE_B, tid, kr[j], vr[j]); }
    }
    const int g = wave & 3, half = wave >> 2, hq = kvh * 4 + g, qpos = q0 + 32 * half + r32;
    bf16x8 qr[4];
#pragma unroll
    for (int d0 = 0; d0 < 4; ++d0) qr[d0] = *(const bf16x8*)(qkv + (size_t)(tok0 + qpos) * 1536 + hq * 64 + d0 * 16 + hi * 8);
    const float slope2 = __builtin_amdgcn_exp2f(-0.5f * (float)(hq + 1)) * LOG2E;
    __syncthreads();
    WS s;
#pragma unroll
    for (int r = 0; r < 16; ++r) { s.o0[r] = 0.f; s.o1[r] = 0.f; }
    s.m = NEGF; s.l = 0.f;
    for (int j = 0; j < 5; ++j) { const int ks = q0 - 128 + 64 * j;
        if (ks >= 0 && ks < 2048) tile_step(s, lds + j * TILE_B, qr, (float)(ks - qpos + 4 * hi), slope2, 128.f, wsf, lane); }
    const float lt = s.l + __shfl_xor(s.l, 32);
    const float inv = 1.0f / (lt + __builtin_amdgcn_exp2f(sink[hq] * LOG2E - s.m));
    store_o(s, inv, O + (size_t)(tok0 + q0 + 32 * half) * 1024 + hq * 64, 1024, wsf, lane);
    __syncthreads();
}

__device__ __forceinline__ void half_barrier(ATT_LAS unsigned* cnt, unsigned& gen) {
    __builtin_amdgcn_fence(__ATOMIC_RELEASE, "workgroup");
    if ((threadIdx.x & 63) == 0) __hip_atomic_fetch_add(cnt, 1u, __ATOMIC_RELAXED, __HIP_MEMORY_SCOPE_WORKGROUP);
    gen += 4u;
    while (__hip_atomic_load(cnt, __ATOMIC_RELAXED, __HIP_MEMORY_SCOPE_WORKGROUP) < gen) __builtin_amdgcn_s_sleep(1);
    __builtin_amdgcn_fence(__ATOMIC_ACQUIRE, "workgroup");
}
__device__ __forceinline__ void attn_b_half(int item, int gi, int dil, const bf16_t* qkv  , bf16_t* O  , float* lse  ,
                                            ATT_LAS char* ldsh, ATT_LAS float* wsf, const int t256, const int wq, const int lane, ATT_LAS unsigned* cnt, unsigned& gen, const bool wg_sync_after_stage) {
    const int r32 = lane & 31, hi = lane >> 5;
    const int h = item & 15, within = (item >> 4) & 15, b = item >> 8;
    const int res = within % dil, qb = within / dil, L = 2048 / dil, u0 = qb * 128, tokb = b * 2048 + res;
    {
        u32x4 kr[8], vr[8];
#pragma unroll
        for (int t = 0; t < 8; ++t) { const int j = t >> 1, pidx = t256 + 256 * (t & 1), ks = u0 - 64 + 64 * j;
            if (ks >= 0 && ks < L) { const bf16_t* src = qkv + (size_t)(tokb + (ks + (pidx >> 3)) * dil) * 3072 + 1024 + h * 64 + (pidx & 7) * 8; kr[t] = *(const u32x4*)src; vr[t] = *(const u32x4*)(src + 1024); } }
#pragma unroll
        for (int t = 0; t < 8; ++t) { const int j = t >> 1, pidx = t256 + 256 * (t & 1), ks = u0 - 64 + 64 * j; if (ks >= 0 && ks < L) stage_write(ldsh + j * TILE_B, pidx, kr[t], vr[t]); }
    }
    const int qpos = u0 + 32 * wq + r32;
    const size_t qtok = (size_t)(tokb + qpos * dil);
    bf16x8 qr[4];
#pragma unroll
    for (int d0 = 0; d0 < 4; ++d0) qr[d0] = *(const bf16x8*)(qkv + qtok * 3072 + h * 64 + d0 * 16 + hi * 8);
    const float slope2 = __builtin_amdgcn_exp2f(-0.5f * (float)(h + 1)) * LOG2E * (float)dil;
    bf16_t* orow0 = O + (size_t)(tokb + (u0 + 32 * wq) * dil) * 1024 + h * 64;
    const size_t rstride = (size_t)dil * 1024;
    WS s;
    if (gi == 0) {
#pragma unroll
        for (int r = 0; r < 16; ++r) { s.o0[r] = 0.f; s.o1[r] = 0.f; }
        s.m = NEGF; s.l = 0.f;
    } else {
        s.m = lse[qtok * 16 + h]; s.l = (hi == 0) ? 1.0f : 0.0f;
#pragma unroll
        for (int r = 0; r < 16; ++r) { const bf16_t* p = orow0 + (size_t)crow(r, hi) * rstride + r32; s.o0[r] = bf2f(p[0]); s.o1[r] = bf2f(p[32]); }
    }
    if (wg_sync_after_stage) __syncthreads();
    half_barrier(cnt, gen);
    for (int jj = 0; jj < 3; ++jj) { const int j = (wq >> 1) + jj, ks = u0 - 64 + 64 * j;
        if (ks >= 0 && ks < L) tile_step(s, ldsh + j * TILE_B, qr, (float)(ks - qpos + 4 * hi), slope2, 64.f, wsf, lane); }
    const float lt = s.l + __shfl_xor(s.l, 32);
    if (hi == 0) lse[qtok * 16 + h] = s.m + __builtin_log2f(lt);
    store_o(s, 1.0f / lt, orow0, rstride, wsf, lane);
    half_barrier(cnt, gen);
}
}

#ifndef MK_MULTI
#define MK_MULTI 0
#endif
#ifndef STAGGER_TICKS
#define STAGGER_TICKS 0
#endif
#ifndef REP_PH
#define REP_PH -1
#endif
#define LAS __attribute__((address_space(3)))
typedef unsigned short bf16;
typedef unsigned v4u __attribute__((ext_vector_type(4)));
typedef float f32x4 __attribute__((ext_vector_type(4)));
constexpr int NWAVES = 8, T = 16 * 2048, D = 1024, FF = 2816, NPH = 16;
constexpr size_t MiB = 1u << 20;
constexpr size_t WS_SSQ = 0, WS_LSE = 2 * MiB;
constexpr size_t WS_WQKVA = 4 * MiB, WS_WOA = 7 * MiB, WS_WGU0 = 9 * MiB, WS_WD0 = 20 * MiB, WS_WQKVB = 26 * MiB, WS_WOB = 44 * MiB, WS_WGU1 = 46 * MiB, WS_WD1 = 57 * MiB;
constexpr size_t WS_CTL = 63 * MiB, CTL_BYTES = 16384;
constexpr int MISC_OFF = 133120;
constexpr size_t WS_XB = 64 * MiB, WS_O = 128 * MiB, WS_BIG = 192 * MiB, WS_END = 384 * MiB;
constexpr int LDS_BYTES = 147456;

__device__ __forceinline__ unsigned f2bf(float f) { unsigned u = __builtin_bit_cast(unsigned, f); return (u + 0x7fffu + ((u >> 16) & 1u)) >> 16; }
__device__ __forceinline__ unsigned pk2(float lo, float hi) { return f2bf(lo) | (f2bf(hi) << 16); }
__device__ __forceinline__ float wave_sum(float v) {
#pragma unroll
    for (int o = 1; o < 64; o <<= 1) v += __shfl_xor(v, o);
    return v;
}
#define XB_TMO      128
#define XB_XCNT(j)  (256  + 64 * (j))
#define XB_XSUB(j)  (1280 + 64 * (j))
#define XB_XGEN(j)  (2304 + 64 * (j))
#define XB_TOP      3328
#define XB_TOPGEN   3392
#define XCD_BAR_WORDS 3456
#define XB_SPIN_CAP (1u << 18)

__device__ __forceinline__ unsigned xb_ld(unsigned* p)              { return __hip_atomic_load(p, __ATOMIC_RELAXED, __HIP_MEMORY_SCOPE_AGENT); }
__device__ __forceinline__ unsigned xb_add(unsigned* p, unsigned v) { return __hip_atomic_fetch_add(p, v, __ATOMIC_RELAXED, __HIP_MEMORY_SCOPE_AGENT); }
__device__ __forceinline__ unsigned xb_xcc_id() { return (unsigned)__builtin_amdgcn_s_getreg((3 << 11) | 20) & 0xFu; }
#define XB_SPIN(cond, bar) do { unsigned _sp = 0; while (cond) { __builtin_amdgcn_s_sleep(1); \
    if ((++_sp & 255u) == 0u) { if (xb_ld(&(bar)[XB_TMO])) break; if (_sp > XB_SPIN_CAP) { atomicAdd(&(bar)[XB_TMO], 1u); break; } } } } while (0)

struct XcdBarrier {
    unsigned* bar; unsigned x;
    volatile LAS unsigned* st;
};

__device__ __forceinline__ XcdBarrier xcd_barrier_post(unsigned* bar, volatile LAS unsigned* st) {
    XcdBarrier b; b.bar = bar; b.x = xb_xcc_id(); b.st = st;
    if (threadIdx.x == 0) (void)xb_add(&bar[XB_XCNT(b.x)], 1u);
    return b;
}
__device__ __forceinline__ void xcd_barrier_complete(unsigned* bar, unsigned x, unsigned& nloc, unsigned& nx) {
    const unsigned G = gridDim.x * gridDim.y * gridDim.z;
    unsigned sum, cnt, mine, sp = 0u;
    for (;;) {
        sum = 0u; cnt = 0u; mine = 0u;
#pragma unroll
        for (unsigned j = 0; j < 16; ++j) { const unsigned c = xb_ld(&bar[XB_XCNT(j)]); sum += c; cnt += (c > 0u) ? 1u : 0u; mine = (j == x) ? c : mine; }
        if (sum == G) break;
        __builtin_amdgcn_s_sleep(1);
        if ((++sp & 255u) == 0u) { if (xb_ld(&bar[XB_TMO])) break; if (sp > XB_SPIN_CAP) { atomicAdd(&bar[XB_TMO], 1u); break; } }
    }
    nloc = mine > 0u ? mine : 1u; nx = cnt > 0u ? cnt : 1u;
}

__device__ __forceinline__ void xcd_barrier(const XcdBarrier& b) {
    asm volatile("s_waitcnt vmcnt(0)" ::: "memory");
    __syncthreads();
    if (threadIdx.x == 0) {
        unsigned* bar = b.bar;
        __builtin_amdgcn_s_waitcnt(0);
        unsigned nloc = b.st[0], nx = b.st[1];
        if (nloc == 0u) { xcd_barrier_complete(bar, b.x, nloc, nx); b.st[0] = nloc; b.st[1] = nx; }
        const unsigned old = xb_add(&bar[XB_XSUB(b.x)], 1u);
        const unsigned gen = old / nloc;
        if (old + 1u == (gen + 1u) * nloc) {
            __builtin_amdgcn_fence(__ATOMIC_RELEASE, "agent");
            asm volatile("s_waitcnt vmcnt(0)" ::: "memory");
            const unsigned og = xb_add(&bar[XB_TOP], 1u);
            const unsigned tg = og / nx;
            if (og + 1u == (tg + 1u) * nx) xb_add(&bar[XB_TOPGEN], 1u);
            else XB_SPIN(xb_ld(&bar[XB_TOPGEN]) == tg, bar);
            __builtin_amdgcn_fence(__ATOMIC_ACQUIRE, "agent");
            xb_add(&bar[XB_XGEN(b.x)], 1u);
            asm volatile("s_waitcnt vmcnt(0)" ::: "memory");
        } else {
            XB_SPIN(xb_ld(&bar[XB_XGEN(b.x)]) == gen, bar);
            __builtin_amdgcn_fence(__ATOMIC_ACQUIRE, "agent");
            asm volatile("s_waitcnt vmcnt(0)" ::: "memory");
        }
    }
    __syncthreads();
}

__device__ __forceinline__ void transpose_item(const float* W, int K, int N, bf16* WT, const float* gs, int mode, LAS float* scr, int item, int lane) {
    const int nblk = N / 32, kb = item / nblk, nb = item % nblk, k0 = 64 * kb, n0 = 32 * nb;
    float wv[32];
#pragma unroll
    for (int i = 0; i < 32; ++i) { const int kk = 2 * i + (lane >> 5); wv[i] = W[(size_t)(k0 + kk) * N + n0 + (lane & 31)]; }
    if (gs) {
#pragma unroll
        for (int i = 0; i < 32; ++i) wv[i] *= gs[k0 + 2 * i + (lane >> 5)];
    }
#pragma unroll
    for (int i = 0; i < 32; ++i) scr[(2 * i + (lane >> 5)) * 33 + (lane & 31)] = wv[i];
    asm volatile("s_waitcnt lgkmcnt(0)" ::: "memory");
    const int c = lane & 7;
    const int rbase = (mode == 0) ? n0 : (256 * (n0 >> 7) + (n0 & 127) + (mode == 2 ? 128 : 0));
#pragma unroll
    for (int j = 0; j < 4; ++j) { const int n = (lane >> 3) + 8 * j; const LAS float* s = scr + (8 * c) * 33 + n;
        v4u o; o.x = pk2(s[0 * 33], s[1 * 33]); o.y = pk2(s[2 * 33], s[3 * 33]); o.z = pk2(s[4 * 33], s[5 * 33]); o.w = pk2(s[6 * 33], s[7 * 33]);
        *(v4u*)(WT + (size_t)(rbase + n) * K + k0 + 8 * c) = o; }
    asm volatile("s_waitcnt lgkmcnt(0)" ::: "memory");
}

struct Args { const float* in[12]; float* out; unsigned char* ws; int ph_lo, ph_hi; };

__global__ void __launch_bounds__(NWAVES * 64, 2) fwd_megakernel(Args a) {
    extern __shared__ __attribute__((aligned(16))) unsigned char lds_raw[];
    LAS unsigned char* lds = (LAS unsigned char*)lds_raw;
    cg::grid_group grid = cg::this_grid();
    const int G = gridDim.x, bid = blockIdx.x;
    unsigned char* ws = a.ws;
    float* ssqp = (float*)(ws + WS_SSQ); float* lse = (float*)(ws + WS_LSE);
    bf16* XB = (bf16*)(ws + WS_XB); bf16* OB = (bf16*)(ws + WS_O); bf16* BIG = (bf16*)(ws + WS_BIG);
    const int NGW = G * NWAVES;
    if (threadIdx.x < 2) ((volatile LAS unsigned*)(lds + MISC_OFF))[threadIdx.x] = 0u;
    __syncthreads();
    XcdBarrier bar = xcd_barrier_post((unsigned*)(ws + WS_CTL), (volatile LAS unsigned*)(lds + MISC_OFF));

    bool rep_done = false;
    for (int ph = a.ph_lo; ph < a.ph_hi; ++ph) {
        int tid = threadIdx.x; asm volatile("" : "+v"(tid));
        const int lane = tid & 63, wave = __builtin_amdgcn_readfirstlane(tid >> 6), gw = bid * NWAVES + wave;
        if (ph == 0) {
            LAS float* scr = (LAS float*)(lds + wave * 16384);
            constexpr int I_QA = 16 * 48, I_O = 16 * 32, I_G = 16 * 88, I_D = 44 * 32, I_QB = 16 * 288;
            constexpr int NITEMS = I_QA + 2 * I_O + 4 * I_G + 2 * I_D + I_QB;
            for (int it = gw; it < NITEMS; it += NGW) {
                int r = it;
                if (r < I_QA) { transpose_item(a.in[3], D, 1536, (bf16*)(ws + WS_WQKVA), a.in[1], 0, scr, r, lane); continue; } r -= I_QA;
                if (r < I_O) { transpose_item(a.in[4], D, D, (bf16*)(ws + WS_WOA), nullptr, 0, scr, r, lane); continue; } r -= I_O;
                if (r < I_O) { transpose_item(a.in[7], D, D, (bf16*)(ws + WS_WOB), nullptr, 0, scr, r, lane); continue; } r -= I_O;
                if (r < I_G) { transpose_item(a.in[8], D, FF, (bf16*)(ws + WS_WGU0), a.in[2], 1, scr, r, lane); continue; } r -= I_G;
                if (r < I_G) { transpose_item(a.in[9], D, FF, (bf16*)(ws + WS_WGU0), a.in[2], 2, scr, r, lane); continue; } r -= I_G;
                if (r < I_G) { transpose_item(a.in[8] + (size_t)D * FF, D, FF, (bf16*)(ws + WS_WGU1), a.in[2] + D, 1, scr, r, lane); continue; } r -= I_G;
                if (r < I_G) { transpose_item(a.in[9] + (size_t)D * FF, D, FF, (bf16*)(ws + WS_WGU1), a.in[2] + D, 2, scr, r, lane); continue; } r -= I_G;
                if (r < I_D) { transpose_item(a.in[10], FF, D, (bf16*)(ws + WS_WD0), nullptr, 0, scr, r, lane); continue; } r -= I_D;
                if (r < I_D) { transpose_item(a.in[10] + (size_t)FF * D, FF, D, (bf16*)(ws + WS_WD1), nullptr, 0, scr, r, lane); continue; } r -= I_D;
                transpose_item(a.in[6], D, 9216, (bf16*)(ws + WS_WQKVB), a.in[1] + D, 0, scr, r, lane);
            }
            for (int m0 = gw * 4; m0 < T; m0 += NGW * 4) {
                f32x4 v[4][4];
#pragma unroll
                for (int q = 0; q < 4; ++q) { const f32x4* xr = (const f32x4*)(a.in[0] + (size_t)(m0 + q) * D) + lane;
#pragma unroll
                    for (int j = 0; j < 4; ++j) v[q][j] = xr[64 * j]; }
#pragma unroll
                for (int q = 0; q < 4; ++q) { float s = 0.f;
#pragma unroll
                    for (int j = 0; j < 4; ++j) s += (v[q][j].x * v[q][j].x + v[q][j].y * v[q][j].y) + (v[q][j].z * v[q][j].z + v[q][j].w * v[q][j].w);
                    s = wave_sum(s);
                    unsigned long long* o8 = (unsigned long long*)(XB + (size_t)(m0 + q) * D) + lane;
#pragma unroll
                    for (int j = 0; j < 4; ++j) o8[64 * j] = (unsigned long long)pk2(v[q][j].x, v[q][j].y) | ((unsigned long long)pk2(v[q][j].z, v[q][j].w) << 32);
                    if (lane < 16) ssqp[(size_t)(m0 + q) * 16 + lane] = (lane == 0) ? s : 0.f; }
            }
            __syncthreads();
        } else if (ph == 1 || ph == 6 || ph == 8 || ph == 10) {
            const int gi = (ph - 6) >> 1;
            const int N = (ph == 1) ? 1536 : 3072;
            const bf16* Bt = (ph == 1) ? (const bf16*)(ws + WS_WQKVA) : (const bf16*)(ws + WS_WQKVB) + (size_t)gi * 3072 * D;
            pg8::Gemm g{XB, Bt, T, N, D}; pg8::StaticOrder S; S.init(T, N, G, bid);
            pg8::EpiQKV E{BIG, N, ssqp, 4};
            if (STAGGER_TICKS > 0 && ph != 1 && (bid & 1)) { const unsigned long long t0 = __builtin_amdgcn_s_memrealtime(); while (__builtin_amdgcn_s_memrealtime() - t0 < (unsigned long long)STAGGER_TICKS) __builtin_amdgcn_s_sleep(32); }
#ifndef DIS_QKV
            pg8::gemm_phase<pg8::EpiQKV, pg8::StaticOrder, true, true>(lds, g, S, E, tid);
#endif
        } else if (ph == 2) {
#ifndef DIS_ATTA
            for (int it = bid; it < 2048; it += G) att::attn_a_item(it, BIG, OB, a.in[5], (LAS char*)lds, tid);
#endif
        } else if (ph == 7 || ph == 9 || ph == 11) {
            const int gi = (ph - 7) >> 1, dil = (gi == 0) ? 1 : (gi == 1 ? 4 : 16);
            {
                const int hh = wave >> 2, halfid = bid * 2 + hh, nhalf = G * 2;
                att::ATT_LAS_U* cnt = (att::ATT_LAS_U*)(lds + MISC_OFF + 64) + hh * 16;
                if (tid < 32) ((att::ATT_LAS_U*)(lds + MISC_OFF + 64))[tid] = 0u;
                __syncthreads();
                unsigned gen = 0u;
                att::ATT_LAS_C* ldsh = (att::ATT_LAS_C*)lds + hh * 65536;
                att::ATT_LAS_F* wsf = (att::ATT_LAS_F*)(lds + att::WSF_OFF) + wave * 64;
                if (hh == 1) __syncthreads();
                bool first = (hh == 0);
                for (int it = halfid; it < 4096; it += nhalf) { att::attn_b_half(it, gi, dil, BIG, OB, lse, ldsh, wsf, tid & 255, wave & 3, lane, cnt, gen, first); first = false; }
            }
        } else if (ph == 3 || ph == 5 || ph == 12 || ph == 14) {
            const bool down = (ph == 5 || ph == 14);
            const bf16* A = down ? BIG : OB;
            const bf16* Bt = (const bf16*)(ws + (ph == 3 ? WS_WOA : ph == 5 ? WS_WD0 : ph == 12 ? WS_WOB : WS_WD1));
            pg8::Gemm g{A, Bt, T, D, down ? FF : D}; pg8::StaticOrder S; S.init(T, D, G, bid);
            pg8::EpiResid E{XB, ssqp};
#ifndef DIS_RES
            pg8::gemm_phase<pg8::EpiResid, pg8::StaticOrder, true, true>(lds, g, S, E, tid);
#endif
        } else if (ph == 4 || ph == 13) {
            const bf16* Bt = (const bf16*)(ws + (ph == 4 ? WS_WGU0 : WS_WGU1));
            pg8::Gemm g{XB, Bt, T, 2 * FF, D}; pg8::StaticOrder S; S.init(T, 2 * FF, G, bid);
            pg8::EpiSwiGLU E{BIG, ssqp};
#ifndef DIS_SWI
            pg8::gemm_phase<pg8::EpiSwiGLU, pg8::StaticOrder, true, true>(lds, g, S, E, tid);
#endif
        } else {
            const float* gf = a.in[11];
            for (int m = gw; m < T; m += NGW) {
                float s = (lane < 16) ? ssqp[(size_t)m * 16 + lane] : 0.f;
                s = wave_sum(s);
                const float r = rsqrtf(s * (1.0f / 1024.0f) + 1e-6f);
                const unsigned long long* xr = (const unsigned long long*)(XB + (size_t)m * D) + lane;
                f32x4* orow = (f32x4*)(a.out + (size_t)m * D) + lane;
#pragma unroll
                for (int j = 0; j < 4; ++j) { const f32x4 gv = ((const f32x4*)gf)[lane + 64 * j]; const unsigned long long w = xr[64 * j]; const unsigned lo = (unsigned)w, hi = (unsigned)(w >> 32);
                    f32x4 v; v.x = __builtin_bit_cast(float, lo << 16); v.y = __builtin_bit_cast(float, lo & 0xffff0000u); v.z = __builtin_bit_cast(float, hi << 16); v.w = __builtin_bit_cast(float, hi & 0xffff0000u);
                    orow[64 * j] = v * r * gv; }
            }
        }
        if (ph + 1 < a.ph_hi) {
            if (a.ph_hi > NPH) { __threadfence(); grid.sync(); __builtin_amdgcn_fence(__ATOMIC_ACQUIRE, "agent"); }
            else xcd_barrier(bar);
        }
        if (REP_PH >= 0 && ph == REP_PH && !rep_done) { rep_done = true; --ph; }
    }
}

extern "C" void kernel_launch(void* const* d_in, const int* in_sizes, int n_in, void* d_out, int out_size, void* d_ws, size_t ws_size, hipStream_t stream) {
    static int grid = 0;
    if (grid == 0) {
        int dev = 0, cus = 0, per_cu = 0;
        if (n_in != 12 || out_size != T * D || ws_size < WS_END) { fprintf(stderr, "kernel_launch: unexpected shapes (n_in %d out %d ws %zu)\n", n_in, out_size, ws_size); grid = -1; return; }
        hipGetDevice(&dev);
        hipDeviceGetAttribute(&cus, hipDeviceAttributeMultiprocessorCount, dev);
        if (hipFuncSetAttribute((const void*)fwd_megakernel, hipFuncAttributeMaxDynamicSharedMemorySize, LDS_BYTES) != hipSuccess) { fprintf(stderr, "kernel_launch: hipFuncSetAttribute failed\n"); grid = -1; return; }
        if (hipOccupancyMaxActiveBlocksPerMultiprocessor(&per_cu, (const void*)fwd_megakernel, NWAVES * 64, LDS_BYTES) != hipSuccess || per_cu < 1) { fprintf(stderr, "kernel_launch: occupancy query says %d\n", per_cu); per_cu = 1; }
        (void)hipGetLastError();
        grid = cus;
        fprintf(stderr, "kernel_launch: grid %d (per_cu %d)\n", grid, per_cu);
    }
    if (grid < 0) return;
    if (hipMemsetAsync((char*)d_ws + WS_CTL, 0, CTL_BYTES, stream) != hipSuccess) { fprintf(stderr, "kernel_launch: memset failed\n"); return; }
    Args a{};
    for (int i = 0; i < 12; ++i) a.in[i] = (const float*)d_in[i];
    a.out = (float*)d_out; a.ws = (unsigned char*)d_ws;
#if MK_MULTI
    for (int ph = 0; ph < NPH; ++ph) {
        a.ph_lo = ph; a.ph_hi = ph + 1;
        void* args[] = {&a};
        hipError_t e = hipLaunchCooperativeKernel((const void*)fwd_megakernel, dim3(grid), dim3(NWAVES * 64), args, LDS_BYTES, stream);
        if (e != hipSuccess) { fprintf(stderr, "launch %d failed: %s\n", ph, hipGetErrorString(e)); break; }
    }
#else
    a.ph_lo = 0; a.ph_hi = NPH;
    void* args[] = {&a};
    hipError_t e = hipLaunchCooperativeKernel((const void*)fwd_megakernel, dim3(grid), dim3(NWAVES * 64), args, LDS_BYTES, stream);
    if (e != hipSuccess) fprintf(stderr, "cooperative launch failed: %s (grid %d)\n", hipGetErrorString(e), grid);
#endif
}
```
